# Optimizing an MI355X kernel written in HIP

```python
import jax, jax.numpy as jnp
from jax import lax
import numpy as np

D_MODEL = 1024
BATCH = 2
SEQ = 8192
DEPTH = 4

D_MIX = D_MODEL
GLA_HEADS = 4
GLA_DK = 64
GLA_DV = 128
GLA_QK = GLA_HEADS * GLA_DK
GLA_WIDTH = GLA_HEADS * GLA_DV
GLA_LOWRANK = 16
GLA_TAU = 16.0
GLA_CHUNK = 64
SSD_HEADS = 8
SSD_HEADDIM = 64
SSD_WIDTH = SSD_HEADS * SSD_HEADDIM
SSD_GROUPS = 2
SSD_STATE = 64
SSD_BC = SSD_GROUPS * SSD_STATE
SSD_CONV = 4
SSD_CONV_DIM = SSD_WIDTH + 2 * SSD_BC
SSD_CHUNK = 128
D_FF = 3584
N_EXPERTS = 8
TOP_K = 2
EPS = 1e-6

IN_SIZES = (GLA_QK, GLA_QK, GLA_WIDTH, GLA_WIDTH, GLA_LOWRANK,
            SSD_WIDTH, SSD_WIDTH, SSD_BC, SSD_BC, SSD_HEADS)
IN_SPLITS = [int(s) for s in np.cumsum(IN_SIZES)[:-1]]
D_IN_PROJ = int(sum(IN_SIZES))

kernel_name = "hybrid_gla_ssd_adaln_moe_trunk"


def rmsnorm(x, w):
    x32 = x.astype(jnp.float32)
    r = x32 * lax.rsqrt(jnp.mean(x32 * x32, axis=-1, keepdims=True) + EPS)
    return (r * w.astype(jnp.float32)).astype(x.dtype)


def inter_chunk_states(decay, contrib):
    d = jnp.moveaxis(decay, 1, 0)
    u = jnp.moveaxis(contrib, 1, 0)

    def step(s, inp):
        dn, un = inp
        return dn * s + un, s

    _, prev = lax.scan(step, jnp.zeros_like(u[0]), (d, u))
    return jnp.moveaxis(prev, 0, 1)


def gla_chunked(q, k, v, log_a):
    bsz, seq, nh, dk = q.shape
    dv = v.shape[-1]
    nc = seq // GLA_CHUNK
    shp = lambda t: t.astype(jnp.float32).reshape(bsz, nc, GLA_CHUNK, nh, t.shape[-1])
    q, k, v, log_a = shp(q) * (dk ** -0.5), shp(k), shp(v), shp(log_a)
    b = jnp.cumsum(log_a, axis=2)
    qe = q * jnp.exp(b)
    ke = k * jnp.exp(-b)
    causal = jnp.tril(jnp.ones((GLA_CHUNK, GLA_CHUNK), bool))
    att = jnp.einsum('bnihd,bnjhd->bnhij', qe, ke)
    att = jnp.where(causal, att, 0.0)
    o_intra = jnp.einsum('bnhij,bnjhv->bnihv', att, v)
    b_last = b[:, :, -1]
    k_tail = k * jnp.exp(b_last[:, :, None] - b)
    contrib = jnp.einsum('bnjhd,bnjhv->bnhdv', k_tail, v)
    s_prev = inter_chunk_states(jnp.exp(b_last)[..., None], contrib)
    o_inter = jnp.einsum('bnihd,bnhdv->bnihv', qe, s_prev)
    return (o_intra + o_inter).reshape(bsz, seq, nh, dv)


def ssd_chunked(xh, dt, a, bm, cm):
    bsz, seq, nh, p = xh.shape
    rep = nh // bm.shape[2]
    nc = seq // SSD_CHUNK
    f = lambda t: t.astype(jnp.float32).reshape((bsz, nc, SSD_CHUNK) + t.shape[2:])
    xh, dt = f(xh), f(dt)
    bh = f(jnp.repeat(bm, rep, axis=2))
    ch = f(jnp.repeat(cm, rep, axis=2))
    cum = jnp.cumsum(dt * a, axis=2)
    causal = jnp.tril(jnp.ones((SSD_CHUNK, SSD_CHUNK), bool))[:, :, None]
    seg = cum[:, :, :, None, :] - cum[:, :, None, :, :]
    decay = jnp.exp(jnp.where(causal, seg, -jnp.inf))
    xdt = xh * dt[..., None]
    scores = jnp.einsum('bnihs,bnjhs->bnijh', ch, bh) * decay
    y_intra = jnp.einsum('bnijh,bnjhp->bnihp', scores, xdt)
    cum_last = cum[:, :, -1]
    contrib = jnp.einsum('bnjhs,bnjhp->bnhps',
                         bh * jnp.exp(cum_last[:, :, None] - cum)[..., None], xdt)
    s_prev = inter_chunk_states(jnp.exp(cum_last)[..., None, None], contrib)
    y_inter = jnp.einsum('bnihs,bnhps->bnihp', ch * jnp.exp(cum)[..., None], s_prev)
    return (y_intra + y_inter).reshape(bsz, seq, nh, p)


def causal_depthwise_conv(u, w, b):
    kw, cdim = w.shape
    out = lax.conv_general_dilated(u, w.astype(u.dtype)[:, None, :], window_strides=(1,),
                                   padding=[(kw - 1, 0)],
                                   dimension_numbers=('NWC', 'WIO', 'NWC'),
                                   feature_group_count=cdim)
    return out + b.astype(u.dtype)


def hybrid_mixer(h, w_in, gla_a_w, gla_a_b, gla_norm_w, conv_w, conv_b,
                 dt_bias, a_log, d_skip, ssd_norm_w, w_out):
    bsz, seq, _ = h.shape
    proj = h @ w_in
    q, k, v, g, alr, z, xs, bm, cm, dt = jnp.split(proj, IN_SPLITS, axis=-1)
    log_a = jax.nn.log_sigmoid((alr @ gla_a_w + gla_a_b).astype(jnp.float32)) / GLA_TAU
    o = gla_chunked(q.reshape(bsz, seq, GLA_HEADS, GLA_DK),
                    k.reshape(bsz, seq, GLA_HEADS, GLA_DK),
                    v.reshape(bsz, seq, GLA_HEADS, GLA_DV),
                    log_a.reshape(bsz, seq, GLA_HEADS, GLA_DK))
    o = rmsnorm(o, gla_norm_w) * jax.nn.silu(g.astype(jnp.float32).reshape(bsz, seq, GLA_HEADS, GLA_DV))
    o = o.reshape(bsz, seq, GLA_WIDTH)
    xbc = jax.nn.silu(causal_depthwise_conv(jnp.concatenate([xs, bm, cm], axis=-1), conv_w, conv_b))
    xs, bm, cm = jnp.split(xbc, [SSD_WIDTH, SSD_WIDTH + SSD_BC], axis=-1)
    dt = jax.nn.softplus(dt.astype(jnp.float32) + dt_bias.astype(jnp.float32))
    a = -jnp.exp(a_log.astype(jnp.float32))
    xh = xs.reshape(bsz, seq, SSD_HEADS, SSD_HEADDIM)
    y = ssd_chunked(xh, dt, a,
                    bm.reshape(bsz, seq, SSD_GROUPS, SSD_STATE),
                    cm.reshape(bsz, seq, SSD_GROUPS, SSD_STATE))
    y = y + d_skip.astype(jnp.float32)[:, None] * xh.astype(jnp.float32)
    y = y.reshape(bsz, seq, SSD_WIDTH) * jax.nn.silu(z.astype(jnp.float32))
    y = rmsnorm(y, ssd_norm_w)
    merged = jnp.concatenate([o, y], axis=-1).astype(h.dtype)
    return merged @ w_out


def swiglu(t, w_gate, w_up, w_down):
    return (jax.nn.silu(t @ w_gate) * (t @ w_up)) @ w_down


def moe_swiglu(h, router_w, w_gate, w_up, w_down):
    bsz, seq, d = h.shape
    t = h.reshape(bsz * seq, d)
    logits = (t @ router_w).astype(jnp.float32)
    top_v, top_i = lax.top_k(logits, TOP_K)
    top_p = jax.nn.softmax(top_v, axis=-1)
    gates = jnp.sum(jax.nn.one_hot(top_i, N_EXPERTS, dtype=jnp.float32) * top_p[..., None], axis=1)
    gates = gates.astype(h.dtype)
    out = jnp.zeros_like(t)
    for e in range(N_EXPERTS):
        out = out + gates[:, e:e + 1] * swiglu(t, w_gate[e], w_up[e], w_down[e])
    return out.reshape(bsz, seq, d)


def setup_inputs(seed: int = 0) -> dict:
    key = jax.random.key(seed)
    ks = iter(list(jax.random.split(key, 40)))
    f32 = jnp.float32
    nrm = lambda shape, scale: jax.random.normal(next(ks), shape, f32) * scale
    n_dense = (DEPTH + 1) // 2
    n_moe = DEPTH // 2
    d = D_MODEL
    x = nrm((BATCH, SEQ, d), 1.0)
    c = nrm((BATCH, d), 1.0)
    ada_w = nrm((DEPTH, d, 6 * d), 0.5 * d ** -0.5)
    ada_b = nrm((DEPTH, 6 * d), 0.02)
    norm1_w = 1.0 + nrm((DEPTH, d), 0.02)
    w_in = nrm((DEPTH, d, D_IN_PROJ), d ** -0.5)
    gla_a_w = nrm((DEPTH, GLA_LOWRANK, GLA_QK), GLA_LOWRANK ** -0.5)
    gla_a_b = nrm((DEPTH, GLA_QK), 0.1)
    gla_norm_w = 1.0 + nrm((DEPTH, GLA_DV), 0.02)
    conv_w = nrm((DEPTH, SSD_CONV, SSD_CONV_DIM), SSD_CONV ** -0.5)
    conv_b = nrm((DEPTH, SSD_CONV_DIM), 0.02)
    dt0 = jnp.exp(jax.random.uniform(next(ks), (DEPTH, SSD_HEADS), f32,
                                     np.log(1e-3).astype(np.float32), np.log(1e-1).astype(np.float32)))
    dt_bias = dt0 + jnp.log(-jnp.expm1(-dt0))
    a_log = jnp.log(jax.random.uniform(next(ks), (DEPTH, SSD_HEADS), f32, 1.0, 16.0))
    d_skip = 1.0 + nrm((DEPTH, SSD_HEADS), 0.1)
    ssd_norm_w = 1.0 + nrm((DEPTH, SSD_WIDTH), 0.02)
    w_out = nrm((DEPTH, D_MIX, d), D_MIX ** -0.5)
    norm2_w = 1.0 + nrm((DEPTH, d), 0.02)
    ffn_w_gate = nrm((n_dense, d, D_FF), d ** -0.5)
    ffn_w_up = nrm((n_dense, d, D_FF), d ** -0.5)
    ffn_w_down = nrm((n_dense, D_FF, d), D_FF ** -0.5)
    router_w = nrm((n_moe, d, N_EXPERTS), d ** -0.5)
    moe_w_gate = nrm((n_moe, N_EXPERTS, d, D_FF), d ** -0.5)
    moe_w_up = nrm((n_moe, N_EXPERTS, d, D_FF), d ** -0.5)
    moe_w_down = nrm((n_moe, N_EXPERTS, D_FF, d), D_FF ** -0.5)
    final_norm_w = 1.0 + nrm((d,), 0.02)
    return {"x": x, "c": c, "ada_w": ada_w, "ada_b": ada_b, "norm1_w": norm1_w,
            "w_in": w_in, "gla_a_w": gla_a_w, "gla_a_b": gla_a_b, "gla_norm_w": gla_norm_w,
            "conv_w": conv_w, "conv_b": conv_b, "dt_bias": dt_bias, "a_log": a_log,
            "d_skip": d_skip, "ssd_norm_w": ssd_norm_w, "w_out": w_out, "norm2_w": norm2_w,
            "ffn_w_gate": ffn_w_gate, "ffn_w_up": ffn_w_up, "ffn_w_down": ffn_w_down,
            "router_w": router_w, "moe_w_gate": moe_w_gate, "moe_w_up": moe_w_up,
            "moe_w_down": moe_w_down, "final_norm_w": final_norm_w}


def reference(x, c, ada_w, ada_b, norm1_w, w_in, gla_a_w, gla_a_b, gla_norm_w,
              conv_w, conv_b, dt_bias, a_log, d_skip, ssd_norm_w, w_out, norm2_w,
              ffn_w_gate, ffn_w_up, ffn_w_down, router_w, moe_w_gate, moe_w_up,
              moe_w_down, final_norm_w):
    s = jax.nn.silu(c)
    for l in range(DEPTH):
        mod = s @ ada_w[l] + ada_b[l]
        sh1, sc1, g1, sh2, sc2, g2 = [m[:, None, :] for m in jnp.split(mod, 6, axis=-1)]
        h = rmsnorm(x, norm1_w[l]) * (1.0 + sc1) + sh1
        mix = hybrid_mixer(h, w_in[l], gla_a_w[l], gla_a_b[l], gla_norm_w[l], conv_w[l],
                           conv_b[l], dt_bias[l], a_log[l], d_skip[l], ssd_norm_w[l], w_out[l])
        x = x + g1 * mix
        h = rmsnorm(x, norm2_w[l]) * (1.0 + sc2) + sh2
        if l % 2 == 0:
            i = l // 2
            ff = swiglu(h, ffn_w_gate[i], ffn_w_up[i], ffn_w_down[i])
        else:
            i = l // 2
            ff = moe_swiglu(h, router_w[i], moe_w_gate[i], moe_w_up[i], moe_w_down[i])
        x = x + g2 * ff
    return rmsnorm(x, final_norm_w)
```

```cpp
#include <hip/hip_runtime.h>
#include <cstdio>
#include <cstdint>

#ifndef MK_PER_PHASE
#define MK_PER_PHASE 0
#endif

#ifndef MK_DBG_SKIP
#define MK_DBG_SKIP 0
#endif
#ifndef MK_MOE_CHECK
#define MK_MOE_CHECK 0
#endif
#ifndef MK_NAIVE_MIX
#define MK_NAIVE_MIX 0
#endif

#define LAS __attribute__((address_space(3)))
#define GAS __attribute__((address_space(1)))
#define DI __device__ __forceinline__
typedef unsigned short bf16;
typedef short bf16x8 __attribute__((ext_vector_type(8)));
typedef short v4i16_t __attribute__((ext_vector_type(4)));
typedef float f32x4 __attribute__((ext_vector_type(4)));
typedef float f32x2 __attribute__((ext_vector_type(2)));
typedef unsigned u32x4 __attribute__((ext_vector_type(4)));
typedef unsigned u32x2 __attribute__((ext_vector_type(2)));
typedef int i32x4 __attribute__((ext_vector_type(4)));
typedef int i32x8 __attribute__((ext_vector_type(8)));

constexpr int BATCH = 2, SEQ = 8192, D = 1024, T = BATCH * SEQ, DEPTH = 4;
constexpr int NPROJ = 2840, NPROJ_PAD = 3072, PROJ_LD = 2816;
constexpr int C_Q = 0, C_K = 256, C_V = 512, C_G = 1024, C_Z = 1536, C_XS = 2048, C_BM = 2560, C_CM = 2688;
constexpr int DFF = 3584, NE = 8;
constexpr int CH = 64, NCH = SEQ / CH, NUNIT = BATCH * NCH;
constexpr float EPS = 1e-6f;
constexpr int MAXTILES = 136;
constexpr int NWAVES = 8, NTHREADS = 512;

constexpr size_t MiB = 1u << 20;
constexpr size_t WS_CTL = 0, CTL_ZERO_BYTES = 1 * MiB;
constexpr size_t WS_MOD = 1 * MiB;
constexpr size_t WS_SMALL = 2 * MiB;
constexpr size_t WS_ROUTE = 4 * MiB;
constexpr size_t WS_ROWINFO = 5 * MiB;
constexpr size_t WS_DECG = 6 * MiB;
constexpr size_t WS_DECS = 7 * MiB;
constexpr size_t WS_BLKCNT = 7 * MiB + 32768;
constexpr size_t WS_WIN = 8 * MiB;
constexpr size_t WS_WOUT = 32 * MiB;
constexpr size_t WS_WGU = 40 * MiB;
constexpr size_t WS_WD = 68 * MiB;
constexpr size_t WS_MGU = 82 * MiB;
constexpr size_t WS_MD = 306 * MiB;
constexpr size_t WS_X = 418 * MiB;
constexpr size_t WS_H = 482 * MiB;
constexpr size_t WS_HTOK = 550 * MiB;
constexpr size_t WS_Y2 = 582 * MiB;
constexpr size_t WS_PROJ = 646 * MiB;
constexpr size_t WS_XBC = 734 * MiB;
constexpr size_t WS_CONTRG = 758 * MiB;
constexpr size_t WS_CONTRS = 790 * MiB;
constexpr size_t WS_SPREVG = 822 * MiB;
constexpr size_t WS_SPREVS = 838 * MiB;
constexpr size_t WS_MERGED = 854 * MiB;
constexpr size_t WS_HID = WS_PROJ;
constexpr size_t WS_SKP = 886 * MiB;
constexpr size_t WS_END = 950 * MiB;
static_assert(WS_HID + (size_t)MAXTILES * 256 * DFF * 2 <= WS_SKP, "HID overlay");
constexpr int CW_BAR = 4096;
constexpr int CW_CNT = 16384;
constexpr int CW_SK = 32768;

constexpr int LDS_BYTES = 163840;
constexpr int MISC_OFF = LDS_BYTES - 1024;

#define RLX_AGENT __ATOMIC_RELAXED, __HIP_MEMORY_SCOPE_AGENT
typedef float cvt_f2 __attribute__((ext_vector_type(2))); typedef __bf16 cvt_b2 __attribute__((ext_vector_type(2)));
DI unsigned pk2(float lo, float hi) { const cvt_f2 v = {lo, hi}; return __builtin_bit_cast(unsigned, __builtin_convertvector(v, cvt_b2)); }
DI unsigned f2bf(float f) { return pk2(f, f) & 0xffffu; }
DI float bf2f(unsigned b) { return __builtin_bit_cast(float, b << 16); }
DI float bflo(unsigned w) { return __builtin_bit_cast(float, w << 16); }
DI float bfhi(unsigned w) { return __builtin_bit_cast(float, w & 0xffff0000u); }
DI float shfl_idx(float v, int src_lane) { return __builtin_bit_cast(float, __builtin_amdgcn_ds_bpermute(src_lane << 2, __builtin_bit_cast(int, v))); }
DI float shfl_xor_l(float v, int o, int lane) { return shfl_idx(v, lane ^ o); }
DI float wave_sum(float v, int lane) {
#pragma unroll
    for (int o = 1; o < 64; o <<= 1) v += shfl_xor_l(v, o, lane);
    return v;
}
DI float silu_f(float x) { return x * __builtin_amdgcn_rcpf(1.0f + __expf(-x)); }
DI float softplus_f(float x) { return x > 20.f ? x : __logf(1.0f + __expf(x)); }
DI float logsigmoid_f(float x) { return fminf(x, 0.f) - __logf(1.0f + __expf(-fabsf(x))); }

DI bf16x8 frag_rowk(const LAS unsigned char* tile, int stride, int row0, int k0, int lane) {
    return *(const LAS bf16x8*)(tile + (row0 + (lane & 15)) * stride + (k0 + 8 * (lane >> 4)) * 2);
}
DI bf16x8 frag_tr(const LAS unsigned char* tile, int stride, int k0, int col0, int lane) {
    const int g = lane >> 4, q = (lane & 15) >> 2, p = lane & 3;
    const LAS unsigned char* a = tile + (k0 + 8 * g + q) * stride + (col0 + 4 * p) * 2;
    const v4i16_t r0 = __builtin_amdgcn_ds_read_tr16_b64_v4i16((LAS v4i16_t*)a);
    const v4i16_t r1 = __builtin_amdgcn_ds_read_tr16_b64_v4i16((LAS v4i16_t*)(a + 4 * stride));
    bf16x8 o; o[0] = r0[0]; o[1] = r0[1]; o[2] = r0[2]; o[3] = r0[3]; o[4] = r1[0]; o[5] = r1[1]; o[6] = r1[2]; o[7] = r1[3]; return o;
}
#define MFMA16(a, b, c) __builtin_amdgcn_mfma_f32_16x16x32_bf16((a), (b), (c), 0, 0, 0)
#define PIN8(a) asm volatile("" : "+v"((a)[0]), "+v"((a)[1]), "+v"((a)[2]), "+v"((a)[3]), "+v"((a)[4]), "+v"((a)[5]), "+v"((a)[6]), "+v"((a)[7]))
#define PIN4(a) asm volatile("" : "+v"((a)[0]), "+v"((a)[1]), "+v"((a)[2]), "+v"((a)[3]))

#define XB_TMO      128
#define XB_XCNT(j)  (256  + 64 * (j))
#define XB_XSUB(j)  (1280 + 64 * (j))
#define XB_XGEN(j)  (2304 + 64 * (j))
#define XB_TOP      3328
#define XB_TOPGEN   3392
#define XCD_BAR_WORDS 3456
#define XB_SPIN_CAP (1u << 20)
DI unsigned xb_ld(unsigned* p)              { return __hip_atomic_load(p, __ATOMIC_RELAXED, __HIP_MEMORY_SCOPE_AGENT); }
DI unsigned xb_add(unsigned* p, unsigned v) { return __hip_atomic_fetch_add(p, v, __ATOMIC_RELAXED, __HIP_MEMORY_SCOPE_AGENT); }
DI unsigned xb_xcc_id() { return (unsigned)__builtin_amdgcn_s_getreg((3 << 11) | 20) & 0xFu; }
#define XB_SPIN(cond, bar) do { unsigned _sp = 0; while (cond) { __builtin_amdgcn_s_sleep(1); \
    if ((++_sp & 255u) == 0u) { if (xb_ld(&(bar)[XB_TMO])) break; if (_sp > XB_SPIN_CAP) { atomicAdd(&(bar)[XB_TMO], 1u); break; } } } } while (0)
struct XcdBarrier { unsigned* bar; unsigned x; volatile LAS unsigned* st; };
DI XcdBarrier xcd_barrier_post(unsigned* bar, volatile LAS unsigned* st, int tid) {
    XcdBarrier b; b.bar = bar; b.x = xb_xcc_id(); b.st = st;
    if (tid == 0) (void)xb_add(&bar[XB_XCNT(b.x)], 1u);
    return b;
}
DI void xcd_barrier_complete(unsigned* bar, unsigned x, unsigned& nloc, unsigned& nx) {
    const unsigned G = gridDim.x * gridDim.y * gridDim.z;
    unsigned sum, cnt, mine, sp = 0u;
    for (;;) {
        sum = 0u; cnt = 0u; mine = 0u;
#pragma unroll 1
        for (unsigned j = 0; j < 16; ++j) { const unsigned c = xb_ld(&bar[XB_XCNT(j)]); sum += c; cnt += (c > 0u) ? 1u : 0u; mine = (j == x) ? c : mine; }
        if (sum == G) break;
        __builtin_amdgcn_s_sleep(1);
        if ((++sp & 255u) == 0u) { if (xb_ld(&bar[XB_TMO])) break; if (sp > XB_SPIN_CAP) { atomicAdd(&bar[XB_TMO], 1u); break; } }
    }
    nloc = mine > 0u ? mine : 1u; nx = cnt > 0u ? cnt : 1u;
}
DI void xcd_barrier(const XcdBarrier& b, int tid) {
    asm volatile("s_waitcnt vmcnt(0)" ::: "memory");
    __syncthreads();
    if (tid == 0) {
        unsigned* bar = b.bar;
        __builtin_amdgcn_s_waitcnt(0);
        unsigned nloc = b.st[0], nx = b.st[1];
        if (nloc == 0u) { xcd_barrier_complete(bar, b.x, nloc, nx); b.st[0] = nloc; b.st[1] = nx; }
        const unsigned old = xb_add(&bar[XB_XSUB(b.x)], 1u);
        const unsigned gen = old / nloc;
        if (old + 1u == (gen + 1u) * nloc) {
            __builtin_amdgcn_fence(__ATOMIC_RELEASE, "agent");
            asm volatile("s_waitcnt vmcnt(0)" ::: "memory");
            const unsigned og = xb_add(&bar[XB_TOP], 1u);
            const unsigned tg = og / nx;
            if (og + 1u == (tg + 1u) * nx) xb_add(&bar[XB_TOPGEN], 1u);
            else XB_SPIN(xb_ld(&bar[XB_TOPGEN]) == tg, bar);
            __builtin_amdgcn_fence(__ATOMIC_ACQUIRE, "agent");
            xb_add(&bar[XB_XGEN(b.x)], 1u);
            asm volatile("s_waitcnt vmcnt(0)" ::: "memory");
        } else {
            XB_SPIN(xb_ld(&bar[XB_XGEN(b.x)]) == gen, bar);
            __builtin_amdgcn_fence(__ATOMIC_ACQUIRE, "agent");
            asm volatile("s_waitcnt vmcnt(0)" ::: "memory");
        }
    }
    __syncthreads();
}

namespace pg8 {
#define PG8_LAS __attribute__((address_space(3)))
typedef unsigned short bf16_t;
constexpr int BM = 256, BK = 64, HALF = 128, HTB = HALF * BK * 2, STAGE_BYTES = 8 * HTB, NXCD = 8, WGM = 8;
__host__ __device__ __forceinline__ int lds_byte(int r, int c) { const int st = (r >> 4) * 2 + (c >> 5), rr = r & 15, cc = c & 31, ob = rr * 64 + cc * 2; return st * 1024 + (ob ^ (((ob >> 9) & 1) << 5)); }
__host__ __device__ __forceinline__ void stage_rc(int b, int& R, int& C) { const int st = b / 1024, sb = b % 1024, swz = sb ^ (((sb >> 9) & 1) << 5); R = (st >> 1) * 16 + swz / 64; C = (st & 1) * 32 + (swz % 64) / 2; }
__host__ __device__ __forceinline__ int perm32(int rho) { const int n = rho >> 4, i = rho & 15; return 8 * (i >> 2) + 4 * n + (i & 3); }
struct Unit { int pm, pn, kt0, nkt, role, slot; };
struct Gemm { const bf16_t* A; const bf16_t* Bt; int M, N, K; };
struct StaticOrder {
    static constexpr bool GATHER = false;
    int nM, nN, nwg, G, c, ntk, ksplit;
    int t1, t2, t3, t4, t5, t6, t7; size_t estride;
    __device__ void init(int nM_, int nN_, int G_, int c_, int ntk_) { nM = nM_; nN = nN_; nwg = nM * nN; G = G_; c = c_; ntk = ntk_; ksplit = 1; t1 = t2 = t3 = t4 = t5 = t6 = t7 = 0x7fffffff; estride = 0; }
    __device__ __forceinline__ bool next(int i, Unit& u) const {
        const long L = (long)i * G + c; if (L >= nwg) return false;
        int wgid = (int)L; { const int q = nwg / NXCD, r = nwg % NXCD, xcd = wgid % NXCD, off = wgid / NXCD; wgid = (xcd < r ? xcd * (q + 1) : r * (q + 1) + (xcd - r) * q) + off; }
        const int nig = WGM * nN, gid = wgid / nig, fm = gid * WGM, gsz = (nM - fm) < WGM ? (nM - fm) : WGM;
        u.pm = fm + ((wgid % nig) % gsz); u.pn = (wgid % nig) / gsz; u.kt0 = 0; u.nkt = ntk; u.role = 0; u.slot = 0;
        if (ksplit == 2) { u.slot = u.pn & 1; u.pn >>= 1; u.nkt = ntk >> 1; u.kt0 = u.slot * u.nkt; }
        return true;
    }
    __device__ __forceinline__ int expert(int pm) const { return (pm >= t1) + (pm >= t2) + (pm >= t3) + (pm >= t4) + (pm >= t5) + (pm >= t6) + (pm >= t7); }
    __device__ __forceinline__ const char* b_base(const Gemm& g, const Unit& u) const { return (const char*)g.Bt + (size_t)expert(u.pm) * estride; }
    __device__ __forceinline__ void a_ready(const Unit&) const {}
    __device__ __forceinline__ void done(const Unit&) const {}
};
struct GatherOrder : StaticOrder {
    static constexpr bool GATHER = true;
    const PG8_LAS unsigned* tok;
    __device__ __forceinline__ void load_offs(int ui, const int (&R)[2], const unsigned (&C)[2], unsigned (&o)[2][2]) const {
#pragma unroll
        for (int h = 0; h < 2; ++h)
#pragma unroll
            for (int i = 0; i < 2; ++i) o[h][i] = tok[ui * 256 + h * 128 + R[i]] + C[i];
    }
};
struct StreamKOrder : StaticOrder {
    int v, R, F;
    __device__ void init_sk(int nM_, int nN_, int G_, int bid, int ntk_) {
        init(nM_, nN_, G_, bid, ntk_); v = (G_ % 8 == 0) ? (bid % 8) * (G_ / 8) + bid / 8 : bid; F = nwg * ntk_; R = (((F + G_ - 1) / G_) + 1) & ~1; }
    __device__ __forceinline__ bool next(int i, Unit& u) const {
        const int start = v * R, end = (start + R < F) ? start + R : F;
        if (start >= F) return false;
        const int u0 = start / ntk, k0 = start - u0 * ntk, ui = u0 + i, fu = ui * ntk, kbeg = i == 0 ? k0 : 0;
        if (fu + kbeg >= end) return false;
        const int kend = (end - fu < ntk) ? end - fu : ntk;
        u.pm = ui / nN; u.pn = ui - u.pm * nN; u.kt0 = kbeg; u.nkt = kend - kbeg;
        u.role = kbeg > 0 ? 1 : (kend < ntk ? 2 : 0); u.slot = kbeg > 0 ? v - 1 : v; return true;
    }
};
__device__ __forceinline__ unsigned cvt_pk_bf16(float lo, float hi) { return ::pk2(lo, hi); }
constexpr float F8_ACT_SCALE = 16.f, F8_W_SCALE = 256.f, F8_Y_SCALE = 32.f;
constexpr int F8_ACT_E8M0 = 0x7b7b7b7b, F8_W_E8M0 = 0x77777777;
constexpr float F8_WG_SCALE = 256.f * 1.4426950408889634f, F8_WU_SCALE = 256.f / 1.4426950408889634f;
constexpr int F8_WU_E8M0 = 0x7b7b7b7b;
__device__ __forceinline__ unsigned cvt_pk4_fp8(float a, float b, float c, float d) {
    int w = 0;
    w = __builtin_amdgcn_cvt_pk_fp8_f32(__builtin_amdgcn_fmed3f(a, -448.f, 448.f), __builtin_amdgcn_fmed3f(b, -448.f, 448.f), w, false);
    w = __builtin_amdgcn_cvt_pk_fp8_f32(__builtin_amdgcn_fmed3f(c, -448.f, 448.f), __builtin_amdgcn_fmed3f(d, -448.f, 448.f), w, true);
    return (unsigned)w;
}
__device__ __forceinline__ i32x8 cat8(bf16x8 lo, bf16x8 hi) { const i32x4 x = __builtin_bit_cast(i32x4, lo), y = __builtin_bit_cast(i32x4, hi); return __builtin_shufflevector(x, y, 0, 1, 2, 3, 4, 5, 6, 7); }

#define PG8_ZERO_INIT_ACC __device__ __forceinline__ void init_acc(f32x4 (&acc)[2][2][4][2], const Unit&, int) const { \
    _Pragma("unroll") for (int a = 0; a < 2; ++a) _Pragma("unroll") for (int b = 0; b < 2; ++b) _Pragma("unroll") for (int m = 0; m < 4; ++m) _Pragma("unroll") for (int n = 0; n < 2; ++n) acc[a][b][m][n] = (f32x4){0.f, 0.f, 0.f, 0.f}; }
struct EpiProj {
    PG8_ZERO_INIT_ACC
    static constexpr bool PERM = true, AFTER_DRAIN = false; static constexpr int W1_E8M0 = F8_W_E8M0;
    bf16_t* P; float* S;
    __device__ __forceinline__ void operator()(const f32x4 (&acc)[2][2][4][2], const Unit& u, int wr, int wc, int fr, int fq) const {
        const int row0 = u.pm * BM + wr * 64 + fr;
        if (u.pn < 11) {
            const int col0 = u.pn * BM + wc * 32 + 8 * fq;
#pragma unroll
            for (int ai = 0; ai < 2; ++ai)
#pragma unroll
                for (int m = 0; m < 4; ++m) { bf16_t* rowp = P + (size_t)(row0 + ai * HALF + m * 16) * PROJ_LD + col0;
#pragma unroll
                    for (int bj = 0; bj < 2; ++bj) { const f32x4 v0 = acc[ai][bj][m][0], v1 = acc[ai][bj][m][1];
                        u32x4 w; w.x = cvt_pk_bf16(v0[0], v0[1]); w.y = cvt_pk_bf16(v0[2], v0[3]); w.z = cvt_pk_bf16(v1[0], v1[1]); w.w = cvt_pk_bf16(v1[2], v1[3]);
                        *(u32x4*)(rowp + bj * HALF) = w; } }
        } else if (wc == 0) {
#pragma unroll
            for (int ai = 0; ai < 2; ++ai)
#pragma unroll
                for (int m = 0; m < 4; ++m) { float* rowp = S + (size_t)(row0 + ai * HALF + m * 16) * 32 + 8 * fq;
                    *(f32x4*)(rowp) = acc[ai][0][m][0]; *(f32x4*)(rowp + 4) = acc[ai][0][m][1]; }
        }
    }
};
struct EpiResid {
    PG8_ZERO_INIT_ACC
    static constexpr bool PERM = true, AFTER_DRAIN = false; static constexpr int W1_E8M0 = F8_W_E8M0;
    const float* basef; bf16_t* X; const float* gate; float gs;
    __device__ __forceinline__ void operator()(const f32x4 (&acc)[2][2][4][2], const Unit& u, int wr, int wc, int fr, int fq) const {
        const int row0 = u.pm * BM + wr * 64 + fr, col0 = u.pn * BM + wc * 32 + 8 * fq;
        const float* gp = gate + (size_t)(u.pm >> 5) * 6144 + col0;
        f32x4 gv[2][2];
#pragma unroll
        for (int bj = 0; bj < 2; ++bj)
#pragma unroll
            for (int n = 0; n < 2; ++n) gv[bj][n] = *(const f32x4*)(gp + bj * HALF + 4 * n) * gs;
        if (basef) {
#pragma unroll
            for (int q2 = 0; q2 < 4; ++q2) { f32x4 b[8];
#pragma unroll
                for (int mm = 0; mm < 2; ++mm) { const int ai = q2 >> 1, m = (q2 & 1) * 2 + mm; const size_t off = (size_t)(row0 + ai * HALF + m * 16) * D + col0;
#pragma unroll
                    for (int bj = 0; bj < 2; ++bj) { b[mm * 4 + bj * 2] = *(const f32x4*)(basef + off + bj * HALF); b[mm * 4 + bj * 2 + 1] = *(const f32x4*)(basef + off + bj * HALF + 4); } }
                PIN8(b);
#pragma unroll
                for (int mm = 0; mm < 2; ++mm) { const int ai = q2 >> 1, m = (q2 & 1) * 2 + mm; const size_t off = (size_t)(row0 + ai * HALF + m * 16) * D + col0;
#pragma unroll
                    for (int bj = 0; bj < 2; ++bj) { const f32x4 v0 = b[mm * 4 + bj * 2] + gv[bj][0] * acc[ai][bj][m][0], v1 = b[mm * 4 + bj * 2 + 1] + gv[bj][1] * acc[ai][bj][m][1];
                        u32x4 w; w.x = cvt_pk_bf16(v0[0], v0[1]); w.y = cvt_pk_bf16(v0[2], v0[3]); w.z = cvt_pk_bf16(v1[0], v1[1]); w.w = cvt_pk_bf16(v1[2], v1[3]);
                        *(u32x4*)(X + off + bj * HALF) = w; } } }
        } else {
#pragma unroll
            for (int ai = 0; ai < 2; ++ai) { u32x4 xb[8];
#pragma unroll
                for (int m = 0; m < 4; ++m) { const size_t off = (size_t)(row0 + ai * HALF + m * 16) * D + col0; xb[2 * m] = *(const u32x4*)(X + off); xb[2 * m + 1] = *(const u32x4*)(X + off + HALF); }
                PIN8(xb);
#pragma unroll
                for (int m = 0; m < 4; ++m) { const size_t off = (size_t)(row0 + ai * HALF + m * 16) * D + col0;
#pragma unroll
                    for (int bj = 0; bj < 2; ++bj) { const u32x4 x = xb[2 * m + bj];
                        const f32x4 b0 = (f32x4){bflo(x.x), bfhi(x.x), bflo(x.y), bfhi(x.y)}, b1 = (f32x4){bflo(x.z), bfhi(x.z), bflo(x.w), bfhi(x.w)};
                        const f32x4 v0 = b0 + gv[bj][0] * acc[ai][bj][m][0], v1 = b1 + gv[bj][1] * acc[ai][bj][m][1];
                        u32x4 w; w.x = cvt_pk_bf16(v0[0], v0[1]); w.y = cvt_pk_bf16(v0[2], v0[3]); w.z = cvt_pk_bf16(v1[0], v1[1]); w.w = cvt_pk_bf16(v1[2], v1[3]);
                        *(u32x4*)(X + off + bj * HALF) = w; } } }
        }
    }
};
template <bool F8> struct EpiSwiglu {
    PG8_ZERO_INIT_ACC
    static constexpr bool PERM = true, AFTER_DRAIN = false; static constexpr int W1_E8M0 = F8_WU_E8M0;
    bf16_t* Hd; int probe;
    __device__ __forceinline__ void operator()(const f32x4 (&acc)[2][2][4][2], const Unit& u, int wr, int wc, int fr, int fq) const {
        if (probe == 3) return;
        const int row0 = u.pm * BM + wr * 64 + fr, col0 = u.pn * HALF + wc * 32 + 8 * fq;
#pragma unroll
        for (int ai = 0; ai < 2; ++ai)
#pragma unroll
            for (int m = 0; m < 4; ++m) {
                float h[8];
#pragma unroll
                for (int n = 0; n < 2; ++n)
#pragma unroll
                    for (int j = 0; j < 4; ++j) { const float gt = acc[ai][0][m][n][j], up = acc[ai][1][m][n][j];
                        if constexpr (F8) h[4 * n + j] = gt * __builtin_amdgcn_rcpf(1.0f + __builtin_amdgcn_exp2f(-gt)) * up;
                        else h[4 * n + j] = gt * __builtin_amdgcn_rcpf(1.0f + __expf(-gt)) * up; }
                if constexpr (F8) { unsigned char* rowp = (unsigned char*)Hd + (size_t)(row0 + ai * HALF + m * 16) * DFF + col0;
                    u32x2 w; w.x = cvt_pk4_fp8(h[0], h[1], h[2], h[3]); w.y = cvt_pk4_fp8(h[4], h[5], h[6], h[7]);
                    if (probe != 2 || w.x == 0x12345678u) *(u32x2*)(rowp) = w; }
                else { bf16_t* rowp = Hd + (size_t)(row0 + ai * HALF + m * 16) * DFF + col0;
                    u32x4 w; w.x = cvt_pk_bf16(h[0], h[1]); w.y = cvt_pk_bf16(h[2], h[3]); w.z = cvt_pk_bf16(h[4], h[5]); w.w = cvt_pk_bf16(h[6], h[7]);
                    if (probe != 2 || w.x == 0x12345678u) *(u32x4*)(rowp) = w; } }
    }
};
struct EpiMoeDown {
    static constexpr bool PERM = true, AFTER_DRAIN = false; static constexpr int W1_E8M0 = F8_W_E8M0;
    bf16_t* Y2; const int* rowinfo;
    bf16_t* Y2b;
    unsigned char* part; unsigned* cnt;
    __device__ __forceinline__ void init_acc(f32x4 (&acc)[2][2][4][2], const Unit& u, int tid) const {
        if (u.role == 2) {
            if (tid < 64) { unsigned sp = 0;
                while ((unsigned)__builtin_amdgcn_readfirstlane((int)__hip_atomic_load(cnt + 64 * u.slot, __ATOMIC_RELAXED, __HIP_MEMORY_SCOPE_AGENT)) < 8u) { __builtin_amdgcn_s_sleep(2); if (++sp > (1u << 20)) break; }
                __builtin_amdgcn_fence(__ATOMIC_ACQUIRE, "agent");
                asm volatile("s_waitcnt vmcnt(0)" ::: "memory"); }
            asm volatile("" ::: "memory"); __builtin_amdgcn_s_barrier(); asm volatile("" ::: "memory");
            int t2 = tid; asm volatile("" : "+v"(t2));
            unsigned char* sb = part + (size_t)u.slot * 262144; sb = (unsigned char*)(((unsigned long long)(unsigned)__builtin_amdgcn_readfirstlane((int)((unsigned long long)sb >> 32)) << 32) | (unsigned)__builtin_amdgcn_readfirstlane((int)(unsigned long long)sb));
            const __amdgpu_buffer_rsrc_t rs = __builtin_amdgcn_make_buffer_rsrc(sb, 0, 262144, 0x00020000);
#pragma unroll
            for (int ai = 0; ai < 2; ++ai)
#pragma unroll
                for (int bj = 0; bj < 2; ++bj)
#pragma unroll
                    for (int m = 0; m < 4; ++m)
#pragma unroll
                        for (int n = 0; n < 2; ++n) acc[ai][bj][m][n] = __builtin_bit_cast(f32x4, __builtin_amdgcn_raw_buffer_load_b128(rs, (unsigned)(((((ai * 2 + bj) * 4 + m) * 2 + n) * 512 + t2) * 16), 0, 16));
        } else {
#pragma unroll
            for (int ai = 0; ai < 2; ++ai)
#pragma unroll
                for (int bj = 0; bj < 2; ++bj)
#pragma unroll
                    for (int m = 0; m < 4; ++m)
#pragma unroll
                        for (int n = 0; n < 2; ++n) acc[ai][bj][m][n] = (f32x4){0.f, 0.f, 0.f, 0.f};
        }
    }
    __device__ __forceinline__ void operator()(f32x4 (&acc)[2][2][4][2], const Unit& u, int wr, int wc, int fr, int fq) const {
        if (u.role == 1) {
            int lane = fq * 16 + fr; asm volatile("" : "+v"(lane)); const int tid = (wr * 4 + wc) * 64 + lane;
            unsigned char* sb = part + (size_t)u.slot * 262144; sb = (unsigned char*)(((unsigned long long)(unsigned)__builtin_amdgcn_readfirstlane((int)((unsigned long long)sb >> 32)) << 32) | (unsigned)__builtin_amdgcn_readfirstlane((int)(unsigned long long)sb));
            const __amdgpu_buffer_rsrc_t rs = __builtin_amdgcn_make_buffer_rsrc(sb, 0, 262144, 0x00020000);
#pragma unroll
            for (int ai = 0; ai < 2; ++ai)
#pragma unroll
                for (int bj = 0; bj < 2; ++bj)
#pragma unroll
                    for (int m = 0; m < 4; ++m)
#pragma unroll
                        for (int n = 0; n < 2; ++n) __builtin_amdgcn_raw_buffer_store_b128(__builtin_bit_cast(u32x4, acc[ai][bj][m][n]), rs, (unsigned)(((((ai * 2 + bj) * 4 + m) * 2 + n) * 512 + tid) * 16), 0, 16);
            asm volatile("s_waitcnt vmcnt(0)" ::: "memory");
            if (lane == 0) __hip_atomic_fetch_add(cnt + 64 * u.slot, 1u, __ATOMIC_RELAXED, __HIP_MEMORY_SCOPE_AGENT);
            return;
        }
        const int row0 = u.pm * BM + wr * 64 + fr, col0 = u.pn * BM + wc * 32 + 8 * fq;
        u32x2 ri[8];
#pragma unroll
        for (int q = 0; q < 8; ++q) ri[q] = *(const u32x2*)(rowinfo + 2 * (row0 + (q >> 2) * HALF + (q & 3) * 16));
        PIN8(ri);
#pragma unroll
        for (int ai = 0; ai < 2; ++ai)
#pragma unroll
            for (int m = 0; m < 4; ++m) { const unsigned tiu = ri[ai * 4 + m].x, pu = ri[ai * 4 + m].y; const int ti = (int)tiu; const float p = __builtin_bit_cast(float, pu);
                if (ti >= 0) { const int tok = ti & 0x3fffffff, k = ti >> 30; unsigned char* rowp = (unsigned char*)((u.role == 0 && u.slot) ? Y2b : Y2) + ((size_t)k * T + tok) * D + col0;
                    const float ps = p * F8_Y_SCALE;
#pragma unroll
                    for (int bj = 0; bj < 2; ++bj) { const f32x4 v0 = acc[ai][bj][m][0] * ps, v1 = acc[ai][bj][m][1] * ps;
                        u32x2 w; w.x = cvt_pk4_fp8(v0[0], v0[1], v0[2], v0[3]); w.y = cvt_pk4_fp8(v1[0], v1[1], v1[2], v1[3]);
                        *(u32x2*)(rowp + bj * HALF) = w; } } }
    }
};

template <class Epi, class Sched, bool ALIGN_EPI = false, bool SP2 = false, bool FP8 = false>
__device__ __forceinline__ void gemm_phase(PG8_LAS unsigned char* lds, const Gemm g, const Sched& S, const Epi& E, const int tid) {
    const int wid = __builtin_amdgcn_readfirstlane(tid >> 6), lane = tid & 63, wr = wid >> 2, wc = wid & 3, fr = lane & 15, fq = lane >> 4;
    const int K = g.K;
    unsigned voffA[2], voffB[2];
#pragma unroll
    for (int i = 0; i < 2; ++i) { int R, C; stage_rc(tid * 16 + i * 8192, R, C); const int Rb = Epi::PERM ? ((R & ~31) + perm32(R & 31)) : R;
        voffA[i] = (unsigned)(R * K + C) * 2u; voffB[i] = (unsigned)(Rb * K + C) * 2u; }
    unsigned cAo[2][2] = {{0u, 0u}, {0u, 0u}}, nAo[2][2] = {{0u, 0u}, {0u, 0u}};
    int gR[2] = {0, 0}; unsigned gC[2] = {0u, 0u};
    if constexpr (Sched::GATHER) {
#pragma unroll
        for (int i = 0; i < 2; ++i) { int R, C; stage_rc(tid * 16 + i * 8192, R, C); gR[i] = R; gC[i] = (unsigned)C * 2u; } }
    const size_t kstep = (size_t)(BK * 2);
    const size_t hstep = (size_t)HALF * K * 2;
    const size_t tstep = 2 * hstep;
    const unsigned ldsw = (unsigned)wid * 1024u;
    const int aoff = lds_byte(wr * 64 + fr, fq * 8), boff = lds_byte(wc * 32 + fr, fq * 8);
#define PG8_SA(b, h) (((b) * 2 + (h)) * HTB)
#define PG8_SB(b, h) ((4 + (b) * 2 + (h)) * HTB)
#define PG8_STAGE(bufoff, gbase, voff) do { _Pragma("unroll") for (int _i = 0; _i < 2; ++_i) \
        __builtin_amdgcn_global_load_lds((const unsigned*)((const char*)(gbase) + (voff)[_i]), (PG8_LAS unsigned*)(lds + (bufoff) + ldsw + _i * 8192), 16, 0, 0); } while (0)
#define PG8_STAGE_A(b, h, gbase, nx) do { if constexpr (Sched::GATHER) { const unsigned _o[2] = {(nx) ? nAo[h][0] : cAo[h][0], (nx) ? nAo[h][1] : cAo[h][1]}; PG8_STAGE(PG8_SA(b, h), gbase, _o); } \
        else { PG8_STAGE(PG8_SA(b, h), (gbase) + (h) * hstep, voffA); } } while (0)
#define PG8_LDA(dst, b, h) do { _Pragma("unroll") for (int m = 0; m < 4; ++m) _Pragma("unroll") for (int k = 0; k < 2; ++k) dst[m][k] = *(const PG8_LAS bf16x8*)(lds + PG8_SA(b, h) + aoff + m * 2048 + k * 1024); } while (0)
#define PG8_LDB(dst, b, h) do { _Pragma("unroll") for (int n = 0; n < 2; ++n) _Pragma("unroll") for (int k = 0; k < 2; ++k) dst[n][k] = *(const PG8_LAS bf16x8*)(lds + PG8_SB(b, h) + boff + n * 2048 + k * 1024); } while (0)
#define PG8_MMA(ai, bj, At, Bt) do { __builtin_amdgcn_s_setprio(1); _Pragma("unroll") for (int m = 0; m < 4; ++m) _Pragma("unroll") for (int n = 0; n < 2; ++n) { \
        if constexpr (FP8) asm volatile("s_nop 1\n\tv_mfma_scale_f32_16x16x128_f8f6f4 %0, %1, %2, %0, %3, %4 op_sel_hi:[0,0,0]" : "+v"(acc[ai][bj][m][n]) : "v"(cat8(Bt[n][0], Bt[n][1])), "v"(cat8(At[m][0], At[m][1])), "v"((bj) == 1 ? Epi::W1_E8M0 : F8_W_E8M0), "v"(F8_ACT_E8M0)); \
        else { _Pragma("unroll") for (int k = 0; k < 2; ++k) acc[ai][bj][m][n] = __builtin_amdgcn_mfma_f32_16x16x32_bf16(Bt[n][k], At[m][k], acc[ai][bj][m][n], 0, 0, 0); } } \
        __builtin_amdgcn_s_setprio(0); } while (0)
#define PG8_WAIT_V(n) asm volatile("s_waitcnt vmcnt(" #n ")" ::: "memory")
#define PG8_WAIT_L(n) asm volatile("s_waitcnt lgkmcnt(" #n ")" ::: "memory")
#define PG8_BAR __builtin_amdgcn_s_barrier()
#define PG8_SCHED __builtin_amdgcn_sched_barrier(0)
    Unit cur, nxt; int ui = 0;
    if (!S.next(0, cur)) return;
    f32x4 acc[2][2][4][2];
    E.init_acc(acc, cur, tid);
    bf16x8 At[4][2], B0[2][2], B1[2][2];
    const char* cA = (const char*)g.A + (Sched::GATHER ? (size_t)0 : (size_t)cur.pm * tstep) + (size_t)cur.kt0 * kstep;
    if constexpr (Sched::GATHER) S.load_offs(0, gR, gC, cAo); const char* cB = S.b_base(g, cur) + (size_t)cur.pn * tstep + (size_t)cur.kt0 * kstep;
    S.a_ready(cur);
    if constexpr (SP2) {
        PG8_STAGE(PG8_SB(0, 0), cB, voffB); PG8_STAGE(PG8_SB(0, 1), cB + hstep, voffB); PG8_STAGE_A(0, 0, cA, false); PG8_STAGE_A(0, 1, cA, false);
        if (wr == 1) PG8_BAR;
        PG8_WAIT_V(2); PG8_BAR;
        PG8_STAGE(PG8_SB(1, 0), cB + kstep, voffB); PG8_STAGE_A(1, 0, cA + kstep, false); PG8_STAGE(PG8_SB(1, 1), cB + hstep + kstep, voffB);
        PG8_WAIT_V(6); PG8_BAR;
    } else {
        PG8_STAGE(PG8_SB(0, 0), cB, voffB); PG8_STAGE_A(0, 0, cA, false); PG8_STAGE(PG8_SB(0, 1), cB + hstep, voffB); PG8_STAGE_A(0, 1, cA, false);
        if (wr == 1) PG8_BAR;
        PG8_WAIT_V(4); PG8_BAR;
        PG8_STAGE(PG8_SB(1, 0), cB + kstep, voffB); PG8_STAGE_A(1, 0, cA + kstep, false); PG8_STAGE(PG8_SB(1, 1), cB + hstep + kstep, voffB);
        PG8_WAIT_V(6); PG8_BAR;
    }
    for (;;) {
        const bool has_next = S.next(ui + 1, nxt);
        const char* nA = has_next ? (const char*)g.A + (Sched::GATHER ? (size_t)0 : (size_t)nxt.pm * tstep) + (size_t)nxt.kt0 * kstep : cA;
        if constexpr (Sched::GATHER) { if (has_next) S.load_offs(ui + 1, gR, gC, nAo); } const char* nB = has_next ? S.b_base(g, nxt) + (size_t)nxt.pn * tstep + (size_t)nxt.kt0 * kstep : cB;
        const int nt = cur.nkt;
        for (int t = 0; t < nt; t += 2) {
            const bool last = (t == nt - 2);
            const bool nx = last && has_next; (void)nx;
            const char* a1 = cA + (size_t)(t + 1) * kstep;
            const char* a2 = last ? nA : cA + (size_t)(t + 2) * kstep; const char* b2 = last ? nB : cB + (size_t)(t + 2) * kstep;
            const char* a3 = a2 + kstep; const char* b3 = b2 + kstep;
            if (last && has_next) S.a_ready(nxt);
            if constexpr (SP2) {
            PG8_LDB(B0, 0, 0); PG8_LDB(B1, 0, 1); PG8_SCHED; PG8_LDA(At, 0, 0); PG8_STAGE_A(1, 1, a1, false);
            PG8_WAIT_V(8); PG8_WAIT_L(0); PG8_BAR; PG8_MMA(0, 0, At, B0); PG8_MMA(0, 1, At, B1); PG8_BAR; PG8_SCHED;
            PG8_LDA(At, 0, 1); PG8_STAGE(PG8_SB(0, 0), b2, voffB); PG8_STAGE(PG8_SB(0, 1), b2 + hstep, voffB); PG8_STAGE_A(0, 0, a2, nx);
            PG8_WAIT_V(8); PG8_WAIT_L(0); PG8_BAR; PG8_MMA(1, 0, At, B0); PG8_MMA(1, 1, At, B1); PG8_BAR; PG8_SCHED;
            PG8_LDB(B0, 1, 0); PG8_LDB(B1, 1, 1); PG8_SCHED; PG8_LDA(At, 1, 0); PG8_STAGE_A(0, 1, a2, nx);
            PG8_WAIT_V(8); PG8_WAIT_L(0); PG8_BAR; PG8_MMA(0, 0, At, B0); PG8_MMA(0, 1, At, B1); PG8_BAR; PG8_SCHED;
            PG8_LDA(At, 1, 1); PG8_STAGE(PG8_SB(1, 0), b3, voffB); PG8_STAGE(PG8_SB(1, 1), b3 + hstep, voffB); PG8_STAGE_A(1, 0, a3, nx);
            PG8_WAIT_V(8); PG8_WAIT_L(0); PG8_BAR; PG8_MMA(1, 0, At, B0); PG8_MMA(1, 1, At, B1); PG8_BAR; PG8_SCHED;
            } else {
            PG8_LDB(B0, 0, 0); PG8_SCHED; PG8_LDA(At, 0, 0); PG8_STAGE_A(1, 1, a1, false);
            PG8_WAIT_L(8); PG8_BAR; PG8_WAIT_L(0); PG8_MMA(0, 0, At, B0); PG8_BAR; PG8_SCHED;
            PG8_LDB(B1, 0, 1); PG8_STAGE(PG8_SB(0, 0), b2, voffB);
            PG8_BAR; PG8_WAIT_L(0); PG8_MMA(0, 1, At, B1); PG8_BAR;
            PG8_LDA(At, 0, 1); PG8_STAGE_A(0, 0, a2, nx);
            PG8_BAR; PG8_WAIT_L(0); PG8_MMA(1, 0, At, B0); PG8_BAR; PG8_SCHED;
            PG8_STAGE(PG8_SB(0, 1), b2 + hstep, voffB);
            PG8_WAIT_V(6); PG8_BAR; PG8_MMA(1, 1, At, B1); PG8_BAR;
            PG8_LDB(B0, 1, 0); PG8_SCHED; PG8_LDA(At, 1, 0); PG8_STAGE_A(0, 1, a2, nx);
            PG8_WAIT_L(8); PG8_BAR; PG8_WAIT_L(0); PG8_MMA(0, 0, At, B0); PG8_BAR; PG8_SCHED;
            PG8_LDB(B1, 1, 1); PG8_STAGE(PG8_SB(1, 0), b3, voffB);
            PG8_BAR; PG8_WAIT_L(0); PG8_MMA(0, 1, At, B1); PG8_BAR;
            PG8_LDA(At, 1, 1); PG8_STAGE_A(1, 0, a3, nx);
            PG8_BAR; PG8_WAIT_L(0); PG8_MMA(1, 0, At, B0); PG8_BAR; PG8_SCHED;
            PG8_STAGE(PG8_SB(1, 1), b3 + hstep, voffB);
            PG8_WAIT_V(6); PG8_BAR; PG8_MMA(1, 1, At, B1); PG8_BAR;
            }
        }
        if constexpr (ALIGN_EPI) { if (wr == 0) PG8_BAR; }
        if constexpr (FP8) asm volatile("s_nop 15\n\ts_nop 15" ::: "memory");
        if constexpr (!Epi::AFTER_DRAIN) { E(acc, cur, wr, wc, fr, fq); S.done(cur); }
        if (!has_next) break;
        E.init_acc(acc, nxt, tid);
        cur = nxt; cA = nA; cB = nB; ++ui;
        if constexpr (Sched::GATHER) { cAo[0][0] = nAo[0][0]; cAo[0][1] = nAo[0][1]; cAo[1][0] = nAo[1][0]; cAo[1][1] = nAo[1][1]; }
        if constexpr (ALIGN_EPI) { if (wr == 1) PG8_BAR; }
    }
    PG8_WAIT_V(0);
    if constexpr (!ALIGN_EPI) { if (wr == 0) PG8_BAR; }
    PG8_BAR;
    if constexpr (Epi::AFTER_DRAIN) { E.fused(acc, cur, wr, wc, fr, fq, lds, wid, lane); S.done(cur); }
#undef PG8_SA
#undef PG8_STAGE_A
#undef PG8_SB
#undef PG8_STAGE
#undef PG8_LDA
#undef PG8_LDB
#undef PG8_MMA
#undef PG8_WAIT_V
#undef PG8_WAIT_L
#undef PG8_BAR
#undef PG8_SCHED
}
}

enum { I_X = 0, I_C, I_ADAW, I_ADAB, I_N1W, I_WIN, I_GAW, I_GAB, I_GNW, I_CONVW, I_CONVB, I_DTB, I_ALOG, I_DSKIP, I_SNW, I_WOUT, I_N2W, I_FG, I_FU, I_FD, I_RW, I_MG, I_MU, I_MD, I_FNW, N_IN };
struct Args { const float* in[N_IN]; float* out; unsigned char* ws; int ph_lo, ph_hi, dummy, pad; };
struct Ctx { unsigned char* ws; const LAS unsigned* tab; };
DI const float* inp(const LAS unsigned* tab, int i) {
    const unsigned lo = (unsigned)__builtin_amdgcn_readfirstlane((int)tab[2 * i]), hi = (unsigned)__builtin_amdgcn_readfirstlane((int)tab[2 * i + 1]);
    return (const float*)(const GAS float*)(((unsigned long long)hi << 32) | lo);
}
#define INP(i) inp(a.tab, (i))

DI void adaln_items(const Ctx& a, LAS unsigned char* lds, int tid, int lane, int wave) {
    LAS float* sl = (LAS float*)lds;
    LAS float* red = (LAS float*)(lds + 8192);
    const float* c = INP(I_C);
    for (int i = tid; i < 2 * D; i += NTHREADS) sl[i] = silu_f(c[i]);
    __syncthreads();
    float* MOD = (float*)(a.ws + WS_MOD);
    for (int item = blockIdx.x; item < 256; item += gridDim.x) {
        const int l = item >> 6, n0 = (item & 63) * 96;
        const int cq = lane % 24, rp = lane / 24;
        f32x4 a0 = {0.f, 0.f, 0.f, 0.f}, a1 = {0.f, 0.f, 0.f, 0.f};
        if (lane < 48) {
            const float* wp = INP(I_ADAW) + ((size_t)l * D + wave * 128 + rp) * 6144 + n0 + 4 * cq;
#pragma unroll 8
            for (int i = 0; i < 64; ++i) { const f32x4 w = *(const f32x4*)(wp + (size_t)(2 * i) * 6144); const int k = wave * 128 + 2 * i + rp; a0 += sl[k] * w; a1 += sl[D + k] * w; }
            LAS float* r0 = red + ((wave * 2 + rp) * 2 + 0) * 96 + 4 * cq; LAS float* r1 = red + ((wave * 2 + rp) * 2 + 1) * 96 + 4 * cq;
            r0[0] = a0[0]; r0[1] = a0[1]; r0[2] = a0[2]; r0[3] = a0[3]; r1[0] = a1[0]; r1[1] = a1[1]; r1[2] = a1[2]; r1[3] = a1[3];
        }
        __syncthreads();
        if (tid < 192) { const int b = tid / 96, col = tid % 96; float s = INP(I_ADAB)[l * 6144 + n0 + col];
#pragma unroll
            for (int q = 0; q < 16; ++q) s += red[(q * 2 + b) * 96 + col];
            MOD[(size_t)(l * 2 + b) * 6144 + n0 + col] = s; }
        __syncthreads();
    }
}
template <int MAP> DI int rowmap(int n) {
    if (MAP == 1) return (n < 1536) ? n : (n < 1552 ? n + 1280 : (n < 2832 ? n - 16 : n));
    if (MAP == 2) return (n >> 7) * 256 + (n & 127);
    if (MAP == 3) return (n >> 7) * 256 + 128 + (n & 127);
    return n;
}
template <int MAP, bool F8 = false> DI void convert_tile(const float* W, int K, int N, bf16* WT, int item, int lane) {
    const int nblk = (N + 63) / 64, kb = item / nblk, nb = item % nblk, k0 = 64 * kb, n0 = 64 * nb;
    const int q = lane >> 4, c = lane & 15, n = n0 + 4 * c;
    if (n >= N) return;
    const float* src = W + (size_t)(k0 + 16 * q) * N + n;
    f32x4 v[16];
#pragma unroll
    for (int i = 0; i < 16; ++i) v[i] = __builtin_nontemporal_load((const f32x4*)(src + (size_t)i * N));
    if constexpr (F8) {
#pragma unroll
        for (int i = 0; i < 16; ++i) v[i] = v[i] * (MAP == 2 ? pg8::F8_WG_SCALE : (MAP == 3 ? pg8::F8_WU_SCALE : pg8::F8_W_SCALE));
#pragma unroll
        for (int j = 0; j < 4; ++j) { unsigned char* dst = (unsigned char*)WT + (size_t)rowmap<MAP>(n + j) * K + k0 + 16 * q;
            u32x4 o; o.x = pg8::cvt_pk4_fp8(v[0][j], v[1][j], v[2][j], v[3][j]); o.y = pg8::cvt_pk4_fp8(v[4][j], v[5][j], v[6][j], v[7][j]);
            o.z = pg8::cvt_pk4_fp8(v[8][j], v[9][j], v[10][j], v[11][j]); o.w = pg8::cvt_pk4_fp8(v[12][j], v[13][j], v[14][j], v[15][j]);
            *(u32x4*)dst = o; }
        return; }
#pragma unroll
    for (int j = 0; j < 4; ++j) { bf16* dst = WT + (size_t)rowmap<MAP>(n + j) * K + k0 + 16 * q;
        u32x4 o0, o1;
        o0.x = pg8::cvt_pk_bf16(v[0][j], v[1][j]); o0.y = pg8::cvt_pk_bf16(v[2][j], v[3][j]); o0.z = pg8::cvt_pk_bf16(v[4][j], v[5][j]); o0.w = pg8::cvt_pk_bf16(v[6][j], v[7][j]);
        o1.x = pg8::cvt_pk_bf16(v[8][j], v[9][j]); o1.y = pg8::cvt_pk_bf16(v[10][j], v[11][j]); o1.z = pg8::cvt_pk_bf16(v[12][j], v[13][j]); o1.w = pg8::cvt_pk_bf16(v[14][j], v[15][j]);
        *(u32x4*)dst = o0; *(u32x4*)(dst + 8) = o1; }
}
DI void convert_weights(const Ctx& a, int lane, int wave) {
    const int gw = blockIdx.x * NWAVES + wave, NGW = gridDim.x * NWAVES;
    constexpr int I_IN = 16 * 45, I_O = 16 * 16, I_GU = 16 * 56, I_D = 56 * 16;
    constexpr int N0 = 4 * I_IN, N1 = N0 + 4 * I_O, N2 = N1 + 2 * I_GU, N3 = N2 + 2 * I_GU, N4 = N3 + 2 * I_D, N5 = N4 + 8 * I_GU, N6 = N5 + 8 * I_GU, N7 = N6 + 8 * I_D;
    unsigned char* ws = a.ws;
    for (int it = gw; it < N7; it += NGW) {
        if (it < N0) { const int m = it / I_IN, r = it % I_IN; convert_tile<1>(INP(I_WIN) + (size_t)m * D * NPROJ, D, NPROJ, (bf16*)(ws + WS_WIN) + (size_t)m * NPROJ_PAD * D, r, lane); }
        else if (it < N1) { const int q = it - N0, m = q / I_O, r = q % I_O; convert_tile<0>(INP(I_WOUT) + (size_t)m * D * D, D, D, (bf16*)(ws + WS_WOUT) + (size_t)m * D * D, r, lane); }
        else if (it < N2) { const int q = it - N1, m = q / I_GU, r = q % I_GU; convert_tile<2, true>(INP(I_FG) + (size_t)m * D * DFF, D, DFF, (bf16*)(ws + WS_WGU + (size_t)m * 2 * DFF * D), r, lane); }
        else if (it < N3) { const int q = it - N2, m = q / I_GU, r = q % I_GU; convert_tile<3, true>(INP(I_FU) + (size_t)m * D * DFF, D, DFF, (bf16*)(ws + WS_WGU + (size_t)m * 2 * DFF * D), r, lane); }
        else if (it < N4) { const int q = it - N3, m = q / I_D, r = q % I_D; convert_tile<0, true>(INP(I_FD) + (size_t)m * DFF * D, DFF, D, (bf16*)(ws + WS_WD + (size_t)m * D * DFF), r, lane); }
        else if (it < N5) { const int q = it - N4, m = q / I_GU, r = q % I_GU; convert_tile<2, true>(INP(I_MG) + (size_t)m * D * DFF, D, DFF, (bf16*)(ws + WS_MGU + (size_t)m * 2 * DFF * D), r, lane); }
        else if (it < N6) { const int q = it - N5, m = q / I_GU, r = q % I_GU; convert_tile<3, true>(INP(I_MU) + (size_t)m * D * DFF, D, DFF, (bf16*)(ws + WS_MGU + (size_t)m * 2 * DFF * D), r, lane); }
        else { const int q = it - N6, m = q / I_D, r = q % I_D; convert_tile<0, true>(INP(I_MD) + (size_t)m * DFF * D, DFF, D, (bf16*)(ws + WS_MD + (size_t)m * D * DFF), r, lane); }
    }
    for (int r = gw; r < 4 * 232; r += NGW) { const int m = r / 232, row = 2840 + r % 232; u32x4* p = (u32x4*)((bf16*)(ws + WS_WIN) + ((size_t)m * NPROJ_PAD + row) * D) + lane;
        const u32x4 z = {0u, 0u, 0u, 0u}; p[0] = z; p[64] = z; }
}
constexpr int MOE_LATE_ITEMS = 8 * (2 * 16 * 56 + 56 * 16), MOE_LATE_SPLIT = 3584;
DI void convert_moe_late(const Ctx& a, int gw, int ngw, int lane, int it0, int it1) {
    constexpr int I_GU = 16 * 56, I_D = 56 * 16, N5 = 8 * I_GU, N6 = N5 + 8 * I_GU, N7 = N6 + 8 * I_D;
    unsigned char* ws = a.ws;
    static_assert(N7 == MOE_LATE_ITEMS, "item count");
    for (int it = it0 + gw; it < it1; it += ngw) {
        if (it < N5) { const int m = 8 + it / I_GU, r = it % I_GU; convert_tile<2, true>(INP(I_MG) + (size_t)m * D * DFF, D, DFF, (bf16*)(ws + WS_MGU + (size_t)m * 2 * DFF * D), r, lane); }
        else if (it < N6) { const int q = it - N5, m = 8 + q / I_GU, r = q % I_GU; convert_tile<3, true>(INP(I_MU) + (size_t)m * D * DFF, D, DFF, (bf16*)(ws + WS_MGU + (size_t)m * 2 * DFF * D), r, lane); }
        else { const int q = it - N6, m = 8 + q / I_D, r = q % I_D; convert_tile<0, true>(INP(I_MD) + (size_t)m * DFF * D, DFF, D, (bf16*)(ws + WS_MD + (size_t)m * D * DFF), r, lane); }
    }
}

struct NormArgs { const float* xin; bf16* X; const float* nw; const float* sc; const float* sh; const float* g2; const bf16* Y2; bf16* H; float* out; int combine; const bf16* Y2b; };
DI void load16b(const bf16* p, int lane, f32x4 (&v)[4]) {
#pragma unroll
    for (int j = 0; j < 4; ++j) { const u32x2 w = *(const u32x2*)(p + 4 * lane + 256 * j); v[j] = (f32x4){bflo(w.x), bfhi(w.x), bflo(w.y), bfhi(w.y)}; }
}
DI void load16(const float* p, int lane, f32x4 (&v)[4]) {
#pragma unroll
    for (int j = 0; j < 4; ++j) v[j] = *(const f32x4*)(p + 4 * lane + 256 * j);
}
template <int MODE> DI void norm_phase(const Ctx& a, const NormArgs& na, LAS unsigned char* lds, int tid, int lane, int wave, const float* router_w, unsigned* cnt) {
    LAS float* WR = (LAS float*)lds;
    LAS int* SEL = (LAS int*)(lds + 32768);
    LAS int* LPOS = (LAS int*)(lds + 32768 + 1024);
    LAS int* BASE = (LAS int*)(lds + 32768 + 2048);
    if (MODE == 1) {
        for (int idx = tid; idx < D * NE; idx += NTHREADS) { const int c = idx >> 3, e = idx & 7, j = c >> 8, ln = (c & 255) >> 2, i = c & 3;
            WR[((((j * 4 + i) * 2 + (e >> 2)) * 64 + ln) << 2) + (e & 3)] = router_w[idx]; }
        __syncthreads(); }
    for (int rb = blockIdx.x * 64; rb < T; rb += gridDim.x * 64) {
        const int r0 = rb + wave * 8, b = r0 / SEQ;
        f32x4 mul[4], add[4], gv[4];
        if (MODE != 2) { f32x4 w[4], s[4]; load16(na.nw, lane, w); load16(na.sc + (size_t)b * 6144, lane, s); load16(na.sh + (size_t)b * 6144, lane, add);
#pragma unroll
            for (int j = 0; j < 4; ++j) mul[j] = w[j] * (1.0f + s[j]); }
        else { load16(na.nw, lane, mul); }
        if ((MODE == 2 && !(MK_DBG_SKIP & 4)) || na.combine) load16(na.g2 + (size_t)b * 6144, lane, gv);
        const bool comb = (MODE == 2 && !(MK_DBG_SKIP & 4)) || na.combine;
        if constexpr (MODE == 1) {
            u32x2 xb[4][4]; f32x4 hk[4][4];
            auto ld = [&](const int rq) {
#pragma unroll
                for (int r4 = 0; r4 < 4; ++r4)
#pragma unroll
                    for (int j = 0; j < 4; ++j) xb[r4][j] = *(const u32x2*)(na.X + (size_t)(r0 + rq + r4) * D + 4 * lane + 256 * j); };
            auto nrm = [&](const int rq) {
#pragma unroll
                for (int r4 = 0; r4 < 4; ++r4) { const size_t row = (size_t)(r0 + rq + r4); f32x4 v[4]; float ss = 0.f;
#pragma unroll
                    for (int j = 0; j < 4; ++j) { const u32x2 w = xb[r4][j]; v[j] = (f32x4){bflo(w.x), bfhi(w.x), bflo(w.y), bfhi(w.y)}; ss += (v[j][0] * v[j][0] + v[j][1] * v[j][1]) + (v[j][2] * v[j][2] + v[j][3] * v[j][3]); }
                    const float rstd = __builtin_amdgcn_rsqf(wave_sum(ss, lane) * (1.0f / D) + EPS);
#pragma unroll
                    for (int j = 0; j < 4; ++j) { const f32x4 h = v[j] * rstd * mul[j] + add[j]; hk[r4][j] = h; const f32x4 hs = h * pg8::F8_ACT_SCALE;
                        *(unsigned*)((unsigned char*)na.H + row * D + 4 * lane + 256 * j) = pg8::cvt_pk4_fp8(hs[0], hs[1], hs[2], hs[3]); } } };
            auto rt = [&](const int rq) {
                f32x2 lg[4][4];
#pragma unroll
                for (int r4 = 0; r4 < 4; ++r4)
#pragma unroll
                    for (int q = 0; q < 4; ++q) lg[r4][q] = (f32x2){0.f, 0.f};
#pragma unroll
                for (int j = 0; j < 4; ++j)
#pragma unroll
                    for (int i = 0; i < 4; ++i) { const LAS f32x4* wr = (const LAS f32x4*)WR + ((j * 4 + i) * 2) * 64 + lane; const f32x4 w0 = wr[0], w1 = wr[64];
                        const f32x2 wp[4] = {{w0[0], w0[1]}, {w0[2], w0[3]}, {w1[0], w1[1]}, {w1[2], w1[3]}};
#pragma unroll
                        for (int r4 = 0; r4 < 4; ++r4) { const float hv = hk[r4][j][i]; const f32x2 hv2 = {hv, hv};
#pragma unroll
                            for (int q = 0; q < 4; ++q) lg[r4][q] += hv2 * wp[q]; }
                        if (i == 1 || i == 3) __builtin_amdgcn_sched_barrier(0); }
#pragma unroll
                for (int r4 = 0; r4 < 4; ++r4) { const int rr = rq + r4;
                    const bool b5 = (lane & 32) != 0, b4 = (lane & 16) != 0, b3 = (lane & 8) != 0;
                    const f32x2 s0 = b5 ? lg[r4][0] : lg[r4][2], s1 = b5 ? lg[r4][1] : lg[r4][3], k0 = b5 ? lg[r4][2] : lg[r4][0], k1 = b5 ? lg[r4][3] : lg[r4][1];
                    f32x2 t0, t1; t0[0] = k0[0] + shfl_xor_l(s0[0], 32, lane); t0[1] = k0[1] + shfl_xor_l(s0[1], 32, lane); t1[0] = k1[0] + shfl_xor_l(s1[0], 32, lane); t1[1] = k1[1] + shfl_xor_l(s1[1], 32, lane);
                    const f32x2 s2 = b4 ? t0 : t1, k2 = b4 ? t1 : t0;
                    f32x2 u; u[0] = k2[0] + shfl_xor_l(s2[0], 16, lane); u[1] = k2[1] + shfl_xor_l(s2[1], 16, lane);
                    float t = (b3 ? u[1] : u[0]) + shfl_xor_l(b3 ? u[0] : u[1], 8, lane);
                    t += shfl_xor_l(t, 4, lane); t += shfl_xor_l(t, 2, lane); t += shfl_xor_l(t, 1, lane);
                    float l8[8];
#pragma unroll
                    for (int e = 0; e < 8; ++e) l8[e] = __builtin_bit_cast(float, __builtin_amdgcn_readlane(__builtin_bit_cast(int, t), 8 * e));
                    int e0 = 0; float v0 = l8[0];
#pragma unroll
                    for (int e = 1; e < 8; ++e) if (l8[e] > v0) { v0 = l8[e]; e0 = e; }
                    int e1 = -1; float v1 = -3.0e38f;
#pragma unroll
                    for (int e = 0; e < 8; ++e) if (e != e0 && l8[e] > v1) { v1 = l8[e]; e1 = e; }
                    const float p0 = __builtin_amdgcn_rcpf(1.0f + __expf(v1 - v0));
                    if (lane == 0) { LAS int* s = SEL + (wave * 8 + rr) * 4; s[0] = e0; s[1] = e1; s[2] = __builtin_bit_cast(int, p0); } } };
            ld(0); PIN8(&xb[0][0]); PIN8(&xb[2][0]);
            nrm(0);
            rt(0); __builtin_amdgcn_sched_barrier(0);
            ld(4); PIN8(&xb[0][0]); PIN8(&xb[2][0]);
            nrm(4);
            rt(4);
        } else
#pragma unroll 1
        for (int rq = 0; rq < 8; rq += 4) {
        f32x4 xf[4][4]; u32x2 xb[4][4]; unsigned ya[4][4], yb[4][4];
        if (na.xin) {
#pragma unroll
            for (int r4 = 0; r4 < 4; ++r4)
#pragma unroll
                for (int j = 0; j < 4; ++j) xf[r4][j] = *(const f32x4*)(na.xin + (size_t)(r0 + rq + r4) * D + 4 * lane + 256 * j);
            PIN8(&xf[0][0]); PIN8(&xf[2][0]);
        } else {
#pragma unroll
            for (int r4 = 0; r4 < 4; ++r4)
#pragma unroll
                for (int j = 0; j < 4; ++j) xb[r4][j] = *(const u32x2*)(na.X + (size_t)(r0 + rq + r4) * D + 4 * lane + 256 * j);
            PIN8(&xb[0][0]); PIN8(&xb[2][0]);
        }
        if (comb) {
#pragma unroll
            for (int r4 = 0; r4 < 4; ++r4)
#pragma unroll
                for (int j = 0; j < 4; ++j) { ya[r4][j] = *(const unsigned*)((const unsigned char*)na.Y2 + (size_t)(r0 + rq + r4) * D + 4 * lane + 256 * j); yb[r4][j] = *(const unsigned*)((const unsigned char*)na.Y2 + ((size_t)T + r0 + rq + r4) * D + 4 * lane + 256 * j); }
            PIN8(&ya[0][0]); PIN8(&ya[2][0]); PIN8(&yb[0][0]); PIN8(&yb[2][0]);
        }
#pragma unroll
        for (int r4 = 0; r4 < 4; ++r4) {
            const int rr = rq + r4, row = r0 + rr;
            f32x4 v[4];
#pragma unroll
            for (int j = 0; j < 4; ++j) { if (na.xin) v[j] = xf[r4][j]; else { const u32x2 w = xb[r4][j]; v[j] = (f32x4){bflo(w.x), bfhi(w.x), bflo(w.y), bfhi(w.y)}; } }
            if (comb) {
#pragma unroll
                for (int j = 0; j < 4; ++j) { const int y0 = (int)ya[r4][j], y1 = (int)yb[r4][j];
                    const f32x2 a0 = __builtin_amdgcn_cvt_pk_f32_fp8(y0, false), a1 = __builtin_amdgcn_cvt_pk_f32_fp8(y0, true), b0 = __builtin_amdgcn_cvt_pk_f32_fp8(y1, false), b1 = __builtin_amdgcn_cvt_pk_f32_fp8(y1, true);
                    f32x4 ys; ys[0] = (a0[0] + b0[0]) * (1.0f / pg8::F8_Y_SCALE); ys[1] = (a0[1] + b0[1]) * (1.0f / pg8::F8_Y_SCALE); ys[2] = (a1[0] + b1[0]) * (1.0f / pg8::F8_Y_SCALE); ys[3] = (a1[1] + b1[1]) * (1.0f / pg8::F8_Y_SCALE);
                    v[j] = v[j] + gv[j] * ys; if (MODE != 2) { u32x2 o; o.x = pk2(v[j][0], v[j][1]); o.y = pk2(v[j][2], v[j][3]); *(u32x2*)(na.X + (size_t)row * D + 4 * lane + 256 * j) = o; } }
            }
            float ss = 0.f;
#pragma unroll
            for (int j = 0; j < 4; ++j) ss += (v[j][0] * v[j][0] + v[j][1] * v[j][1]) + (v[j][2] * v[j][2] + v[j][3] * v[j][3]);
            const float rstd = __builtin_amdgcn_rsqf(wave_sum(ss, lane) * (1.0f / D) + EPS);
            if (MODE == 2) {
#pragma unroll
                for (int j = 0; j < 4; ++j) *(f32x4*)(na.out + (size_t)row * D + 4 * lane + 256 * j) = v[j] * rstd * mul[j];
            } else {
                f32x4 h[4];
#pragma unroll
                for (int j = 0; j < 4; ++j) { h[j] = v[j] * rstd * mul[j] + add[j];
                    if (MODE == 1 || MODE == 3) { const f32x4 hs = h[j] * pg8::F8_ACT_SCALE; *(unsigned*)((unsigned char*)na.H + (size_t)row * D + 4 * lane + 256 * j) = pg8::cvt_pk4_fp8(hs[0], hs[1], hs[2], hs[3]); }
                    else { u32x2 o; o.x = pk2(h[j][0], h[j][1]); o.y = pk2(h[j][2], h[j][3]); *(u32x2*)(na.H + (size_t)row * D + 4 * lane + 256 * j) = o; } }
                if (MODE == 1) {
                    float lg[8];
#pragma unroll
                    for (int e = 0; e < 8; ++e) lg[e] = 0.f;
#pragma unroll
                    for (int j = 0; j < 4; ++j)
#pragma unroll
                        for (int i = 0; i < 4; ++i) { const LAS f32x4* wr = (const LAS f32x4*)WR + ((j * 4 + i) * 2) * 64 + lane; const f32x4 w0 = wr[0], w1 = wr[64]; const float hv = h[j][i];
                            lg[0] += hv * w0[0]; lg[1] += hv * w0[1]; lg[2] += hv * w0[2]; lg[3] += hv * w0[3]; lg[4] += hv * w1[0]; lg[5] += hv * w1[1]; lg[6] += hv * w1[2]; lg[7] += hv * w1[3]; }
#pragma unroll
                    for (int e = 0; e < 8; ++e) lg[e] = wave_sum(lg[e], lane);
                    int e0 = 0; float v0 = lg[0];
#pragma unroll
                    for (int e = 1; e < 8; ++e) if (lg[e] > v0) { v0 = lg[e]; e0 = e; }
                    int e1 = -1; float v1 = -3.0e38f;
#pragma unroll
                    for (int e = 0; e < 8; ++e) if (e != e0 && lg[e] > v1) { v1 = lg[e]; e1 = e; }
                    const float p0 = 1.0f / (1.0f + expf(v1 - v0));
                    if (lane == 0) { LAS int* s = SEL + (wave * 8 + rr) * 4; s[0] = e0; s[1] = e1; s[2] = __builtin_bit_cast(int, p0); }
                }
            }
        }
        }
        if (MODE == 1) {
            __syncthreads();
            if (tid < 64) {
                const int e0 = SEL[tid * 4], e1 = SEL[tid * 4 + 1]; const unsigned long long lt = (1ull << tid) - 1ull; int r0 = 0, r1 = 0;
#pragma unroll
                for (int e = 0; e < 8; ++e) { const unsigned long long m0 = __ballot(e0 == e), m1 = __ballot(e1 == e); const int below = __popcll(m0 & lt) + __popcll(m1 & lt);
                    if (e0 == e) r0 = below; if (e1 == e) r1 = below;
                    if (tid == e) ((int*)(a.ws + WS_BLKCNT))[(rb >> 6) * 8 + e] = __popcll(m0) + __popcll(m1); }
                LPOS[tid * 2] = r0; LPOS[tid * 2 + 1] = r1; }
            __syncthreads();
            if (tid < 64) { const int e0 = SEL[tid * 4], e1 = SEL[tid * 4 + 1]; i32x4 o; o.x = e0 | (e1 << 8); o.y = LPOS[tid * 2]; o.z = LPOS[tid * 2 + 1]; o.w = SEL[tid * 4 + 2];
                *(i32x4*)(a.ws + WS_ROUTE + (size_t)(rb + tid) * 16) = o; }
            __syncthreads();
        }
    }
}
DI void moe_offsets(const unsigned* cnt, int (&off)[9]) {
    int o = 0;
#pragma unroll
    for (int e = 0; e < 8; ++e) { off[e] = o; const int c = (int)__hip_atomic_load(cnt + 64 * e, RLX_AGENT); o += ((c + 255) >> 8) << 8; }
    off[8] = o;
}
DI void moe_permute(const Ctx& a, unsigned* cnt, LAS unsigned char* lds, int tid, int lane, int wave) {
    LAS int* BASE = (LAS int*)lds;
    LAS int* TOT = BASE + 2048;
    const int* BC = (const int*)(a.ws + WS_BLKCNT);
    {
        LAS int* CNT = TOT + 64;
        *(LAS i32x4*)(CNT + 4 * tid) = *(const i32x4*)(BC + 4 * tid);
        __syncthreads();
        int c[4], s = 0;
#pragma unroll
        for (int i = 0; i < 4; ++i) { c[i] = CNT[(4 * lane + i) * 8 + wave]; s += c[i]; }
        int incl = s;
#pragma unroll
        for (int o = 1; o < 64; o <<= 1) { const int t = __builtin_amdgcn_ds_bpermute((lane - o) << 2, incl); if (lane >= o) incl += t; }
        int run = incl - s;
#pragma unroll
        for (int i = 0; i < 4; ++i) { BASE[(4 * lane + i) * 8 + wave] = run; run += c[i]; }
        if (lane == 63) { TOT[wave] = incl; if (blockIdx.x == 0) __hip_atomic_store(cnt + 64 * wave, (unsigned)incl, RLX_AGENT); }
    }
    __syncthreads();
    int off[9]; { int o = 0;
#pragma unroll
        for (int e = 0; e < 8; ++e) { off[e] = o; o += ((TOT[e] + 255) >> 8) << 8; }
        off[8] = o; }
    (void)lane; (void)wave;
    int* RI = (int*)(a.ws + WS_ROWINFO);
    for (int t = blockIdx.x * NTHREADS + tid; t < T; t += gridDim.x * NTHREADS) {
        const i32x4 r = *(const i32x4*)(a.ws + WS_ROUTE + (size_t)t * 16);
        const int rx = r.x, ry = r.y, rz = r.z, rw = r.w; const int e0 = rx & 255, e1 = (rx >> 8) & 255; const float p0 = __builtin_bit_cast(float, rw);
        int d0 = ry + BASE[(t >> 6) * 8 + e0], d1 = rz + BASE[(t >> 6) * 8 + e1];
#pragma unroll
        for (int e = 0; e < 8; ++e) { d0 += (e0 == e) ? off[e] : 0; d1 += (e1 == e) ? off[e] : 0; }
        u32x2 w0, w1; w0.x = (unsigned)t; w0.y = __builtin_bit_cast(unsigned, p0); w1.x = (unsigned)t | (1u << 30); w1.y = __builtin_bit_cast(unsigned, 1.0f - p0);
        *(u32x2*)(RI + 2 * d0) = w0; *(u32x2*)(RI + 2 * d1) = w1;
    }
    int neg1 = -1; asm volatile("" : "+v"(neg1));
#pragma unroll
    for (int e = 0; e < 8; ++e) {
        const int c = TOT[e], beg = off[e] + c, end = off[e + 1];
        for (int r = beg + blockIdx.x * NTHREADS + tid; r < end; r += gridDim.x * NTHREADS) { RI[2 * r] = neg1; RI[2 * r + 1] = 0; }
    }
}

struct MixArgs { const float* gaw; const float* gab; const float* gnw; const float* convw; const float* convb; const float* dtb; const float* alog; const float* dskip; const float* snw; };

DI void gla_load_aw(const MixArgs& m, int tid, float (&aw)[17]) {
    const int hd = tid & 255;
#pragma unroll
    for (int r = 0; r < 16; ++r) aw[r] = m.gaw[r * 256 + hd];
    aw[16] = m.gab[hd];
}
DI float gla_cumsum(const float (&aw)[17], const LAS float* ALR, LAS float* HTOT, int tid, float (&cs)[32]) {
    const int hd = tid & 255, half = tid >> 8;
    const float ab = aw[16];
    float run = 0.f;
#pragma unroll
    for (int jj = 0; jj < 32; ++jj) { const LAS f32x4* ar = (const LAS f32x4*)(ALR + (half * 32 + jj) * 16); float x = ab;
#pragma unroll
        for (int q = 0; q < 4; ++q) { const f32x4 v = ar[q]; x += v[0] * aw[4 * q] + v[1] * aw[4 * q + 1] + v[2] * aw[4 * q + 2] + v[3] * aw[4 * q + 3]; }
        run += logsigmoid_f(x) * (1.0f / 16.0f); cs[jj] = run; }
    HTOT[half * 256 + hd] = run;
    __syncthreads();
    const float t0 = HTOT[hd], t1 = HTOT[256 + hd];
    if (half) {
#pragma unroll
        for (int jj = 0; jj < 32; ++jj) cs[jj] += t0; }
    return t0 + t1;
}
DI void ssd_dt_cum(const MixArgs& m, const float* SMALL, int r0, LAS float* DT, LAS float* CUM, int lane, int wave, float& cum_last) {
    const int h = wave;
    const float dt = softplus_f(SMALL[(size_t)(r0 + lane) * 32 + 16 + h] + m.dtb[h]);
    const float av = -__expf(m.alog[h]);
    float c = dt * av;
#pragma unroll
    for (int o = 1; o < 64; o <<= 1) { const float t = shfl_idx(c, lane - o); if (lane >= o) c += t; }
    DT[lane * 8 + h] = dt; CUM[lane * 8 + h] = c;
    cum_last = shfl_idx(c, 63);
}

DI MixArgs mk_mix(const Ctx& a, int l) {
    MixArgs m; m.gaw = INP(I_GAW) + (size_t)l * 16 * 256; m.gab = INP(I_GAB) + (size_t)l * 256; m.gnw = INP(I_GNW) + (size_t)l * 128; m.convw = INP(I_CONVW) + (size_t)l * 4 * 768; m.convb = INP(I_CONVB) + (size_t)l * 768;
    m.dtb = INP(I_DTB) + (size_t)l * 8; m.alog = INP(I_ALOG) + (size_t)l * 8; m.dskip = INP(I_DSKIP) + (size_t)l * 8; m.snw = INP(I_SNW) + (size_t)l * 512; return m;
}
DI void phase_s1(const Ctx& a, const MixArgs& m, LAS unsigned char* lds, int tid, int lane, int wave) {
    const bf16* PROJ = (const bf16*)(a.ws + WS_PROJ); const float* SMALL = (const float*)(a.ws + WS_SMALL);
    bf16* XBC = (bf16*)(a.ws + WS_XBC);
    bf16* CG = (bf16*)(a.ws + WS_CONTRG); bf16* CS = (bf16*)(a.ws + WS_CONTRS); float* DECG = (float*)(a.ws + WS_DECG); float* DECS = (float*)(a.ws + WS_DECS);
    const int g = lane >> 4, fr = lane & 15;
#ifndef MK_S1_REP_G
#define MK_S1_REP_G 1
#endif
#ifndef MK_S1_REP_S
#define MK_S1_REP_S 1
#endif
    for (int rep_g = 0; rep_g < MK_S1_REP_G; ++rep_g)
    for (int u = blockIdx.x; u < NUNIT; u += gridDim.x) {
        const int b = u / NCH, c = u % NCH, r0 = b * SEQ + c * CH;
        {
            LAS float* ALR = (LAS float*)lds;
            LAS unsigned char* KT = lds + 4096;
            LAS unsigned char* VN = lds + 40960;
            LAS float* HTOT = (LAS float*)(lds + 107520);
            LAS unsigned char* KR = lds + 109568;
            float aw[17];
            {
              f32x4 ta = {0.f, 0.f, 0.f, 0.f}; u32x4 tv[8], tk[4];
              gla_load_aw(m, tid, aw);
              if (tid < 256) ta = *(const f32x4*)(SMALL + (size_t)(r0 + (tid >> 2)) * 32 + 4 * (tid & 3));
#pragma unroll
              for (int i = 0; i < 8; ++i) { const int id = tid + NTHREADS * i, row = id >> 6, cp = id & 63; tv[i] = *(const u32x4*)(PROJ + (size_t)(r0 + row) * PROJ_LD + C_V + cp * 8); }
#pragma unroll
              for (int i = 0; i < 4; ++i) { const int id = tid + NTHREADS * i, row = id >> 5, cp = id & 31; tk[i] = *(const u32x4*)(PROJ + (size_t)(r0 + row) * PROJ_LD + C_K + cp * 8); }
              PIN8(tv); PIN4(tk); asm volatile("" : "+v"(ta));
              if (tid < 256) *(LAS f32x4*)(ALR + (tid >> 2) * 16 + 4 * (tid & 3)) = ta;
#pragma unroll
              for (int i = 0; i < 8; ++i) { const int id = tid + NTHREADS * i, row = id >> 6, cp = id & 63; *(LAS u32x4*)(VN + row * 1040 + cp * 16) = tv[i]; }
#pragma unroll
              for (int i = 0; i < 4; ++i) { const int id = tid + NTHREADS * i, row = id >> 5, cp = id & 31; *(LAS u32x4*)(KR + row * 528 + cp * 16) = tk[i]; } }
            __syncthreads();
            float cs[32];
            const float blast = gla_cumsum(aw, ALR, HTOT, tid, cs);
            const int hd = tid & 255, half = tid >> 8;
            if (half == 0) DECG[(size_t)u * 256 + hd] = __expf(blast);
#pragma unroll
            for (int j8 = 0; j8 < 4; ++j8) { float kt[8];
#pragma unroll
                for (int e = 0; e < 8; ++e) { const int jj = j8 * 8 + e; const float kv = bf2f(*(const LAS bf16*)(KR + (half * 32 + jj) * 528 + hd * 2)); kt[e] = kv * __expf(blast - cs[jj]); }
                u32x4 w; w.x = pk2(kt[0], kt[1]); w.y = pk2(kt[2], kt[3]); w.z = pk2(kt[4], kt[5]); w.w = pk2(kt[6], kt[7]);
                *(LAS u32x4*)(KT + hd * 144 + (half * 32 + j8 * 8) * 2) = w; }
            __syncthreads();
            const int h = wave >> 1, vh = wave & 1;
            f32x4 acc[4][4];
#pragma unroll
            for (int dt = 0; dt < 4; ++dt)
#pragma unroll
                for (int vt = 0; vt < 4; ++vt) acc[dt][vt] = (f32x4){0.f, 0.f, 0.f, 0.f};
#pragma unroll
            for (int ks = 0; ks < 2; ++ks) { bf16x8 af[4], bfr[4];
#pragma unroll
                for (int dt = 0; dt < 4; ++dt) af[dt] = frag_rowk(KT, 144, h * 64 + 16 * dt, 32 * ks, lane);
#pragma unroll
                for (int vt = 0; vt < 4; ++vt) bfr[vt] = frag_tr(VN, 1040, 32 * ks, h * 128 + vh * 64 + 16 * vt, lane);
#pragma unroll
                for (int dt = 0; dt < 4; ++dt)
#pragma unroll
                    for (int vt = 0; vt < 4; ++vt) acc[dt][vt] = MFMA16(af[dt], bfr[vt], acc[dt][vt]); }
            bf16* cg = CG + ((size_t)u * 4 + h) * 8192;
#pragma unroll
            for (int dt = 0; dt < 4; ++dt)
#pragma unroll
                for (int vt = 0; vt < 4; ++vt) { u32x2 w; w.x = pk2(acc[dt][vt][0], acc[dt][vt][1]); w.y = pk2(acc[dt][vt][2], acc[dt][vt][3]); *(u32x2*)(cg + (vh * 64 + 16 * vt + fr) * 64 + 16 * dt + 4 * g) = w; }
            __syncthreads();
        }
    }
    for (int rep_s = 0; rep_s < MK_S1_REP_S; ++rep_s)
    for (int u = blockIdx.x; u < NUNIT; u += gridDim.x) {
        const int b = u / NCH, c = u % NCH, r0 = b * SEQ + c * CH; (void)b; (void)c;
        {
            LAS float* DT = (LAS float*)lds;
            LAS float* CUM = (LAS float*)(lds + 2048);
            LAS float* WJ = (LAS float*)(lds + 4096);
            LAS unsigned char* XW = lds + 8192;
            LAS unsigned char* BN = lds + 74752;
            float cum_last; ssd_dt_cum(m, SMALL, r0, DT, CUM, lane, wave, cum_last);
            WJ[lane * 8 + wave] = DT[lane * 8 + wave] * __expf(cum_last - CUM[lane * 8 + wave]);
            if (lane == 0) DECS[(size_t)u * 8 + wave] = __expf(cum_last);
            __syncthreads();
            for (int it = tid; it < 768; it += NTHREADS) {
                const int cg8 = it % 96, tb = it / 96, ch0 = cg8 * 8, j0 = tb * 8;
                float wgt[4][8], bias[8];
#pragma unroll
                for (int k = 0; k < 4; ++k) { const f32x4 w0 = *(const f32x4*)(m.convw + k * 768 + ch0), w1 = *(const f32x4*)(m.convw + k * 768 + ch0 + 4);
                    wgt[k][0] = w0[0]; wgt[k][1] = w0[1]; wgt[k][2] = w0[2]; wgt[k][3] = w0[3]; wgt[k][4] = w1[0]; wgt[k][5] = w1[1]; wgt[k][6] = w1[2]; wgt[k][7] = w1[3]; }
                { const f32x4 b0 = *(const f32x4*)(m.convb + ch0), b1 = *(const f32x4*)(m.convb + ch0 + 4); bias[0] = b0[0]; bias[1] = b0[1]; bias[2] = b0[2]; bias[3] = b0[3]; bias[4] = b1[0]; bias[5] = b1[1]; bias[6] = b1[2]; bias[7] = b1[3]; }
                u32x4 raw[11];
#pragma unroll
                for (int r = 0; r < 11; ++r) { const int j = j0 - 3 + r; const bool ok = (c * CH + j) >= 0;
                    raw[r] = ok ? *(const u32x4*)(PROJ + (size_t)(r0 + j) * PROJ_LD + C_XS + ch0) : (u32x4){0u, 0u, 0u, 0u}; }
#pragma unroll
                for (int jj = 0; jj < 8; ++jj) { float o[8];
#pragma unroll
                    for (int i = 0; i < 8; ++i) o[i] = bias[i];
#pragma unroll
                    for (int k = 0; k < 4; ++k) { const u32x4 rv = raw[jj + k];
                        o[0] += wgt[k][0] * bflo(rv.x); o[1] += wgt[k][1] * bfhi(rv.x); o[2] += wgt[k][2] * bflo(rv.y); o[3] += wgt[k][3] * bfhi(rv.y);
                        o[4] += wgt[k][4] * bflo(rv.z); o[5] += wgt[k][5] * bfhi(rv.z); o[6] += wgt[k][6] * bflo(rv.w); o[7] += wgt[k][7] * bfhi(rv.w); }
#pragma unroll
                    for (int i = 0; i < 8; ++i) o[i] = silu_f(o[i]);
                    const int j = j0 + jj;
                    u32x4 w; w.x = pk2(o[0], o[1]); w.y = pk2(o[2], o[3]); w.z = pk2(o[4], o[5]); w.w = pk2(o[6], o[7]);
                    *(u32x4*)(XBC + (size_t)(r0 + j) * 768 + ch0) = w;
                    if (ch0 < 512) { const float wj = WJ[j * 8 + (ch0 >> 6)];
                        u32x4 x; x.x = pk2(bflo(w.x) * wj, bfhi(w.x) * wj); x.y = pk2(bflo(w.y) * wj, bfhi(w.y) * wj); x.z = pk2(bflo(w.z) * wj, bfhi(w.z) * wj); x.w = pk2(bflo(w.w) * wj, bfhi(w.w) * wj);
                        *(LAS u32x4*)(XW + j * 1040 + ch0 * 2) = x; }
                    else if (ch0 < 640) *(LAS u32x4*)(BN + j * 272 + (ch0 - 512) * 2) = w; }
            }
            __syncthreads();
            const int h = wave, gi = h >> 2;
            f32x4 acc[4][4];
#pragma unroll
            for (int st = 0; st < 4; ++st)
#pragma unroll
                for (int pt = 0; pt < 4; ++pt) acc[st][pt] = (f32x4){0.f, 0.f, 0.f, 0.f};
#pragma unroll
            for (int ks = 0; ks < 2; ++ks) { bf16x8 af[4], bfr[4];
#pragma unroll
                for (int st = 0; st < 4; ++st) af[st] = frag_tr(BN, 272, 32 * ks, gi * 64 + 16 * st, lane);
#pragma unroll
                for (int pt = 0; pt < 4; ++pt) bfr[pt] = frag_tr(XW, 1040, 32 * ks, h * 64 + 16 * pt, lane);
#pragma unroll
                for (int st = 0; st < 4; ++st)
#pragma unroll
                    for (int pt = 0; pt < 4; ++pt) acc[st][pt] = MFMA16(af[st], bfr[pt], acc[st][pt]); }
            bf16* csp = CS + ((size_t)u * 8 + h) * 4096;
#pragma unroll
            for (int st = 0; st < 4; ++st)
#pragma unroll
                for (int pt = 0; pt < 4; ++pt) { u32x2 w; w.x = pk2(acc[st][pt][0], acc[st][pt][1]); w.y = pk2(acc[st][pt][2], acc[st][pt][3]); *(u32x2*)(csp + (16 * pt + fr) * 64 + 16 * st + 4 * g) = w; }
            __syncthreads();
        }
    }
}

DI void phase_scan(const Ctx& a, int tid) {
    const bf16* CG = (const bf16*)(a.ws + WS_CONTRG); const bf16* CS = (const bf16*)(a.ws + WS_CONTRS);
    const float* DECG = (const float*)(a.ws + WS_DECG); const float* DECS = (const float*)(a.ws + WS_DECS);
    bf16* SG = (bf16*)(a.ws + WS_SPREVG); bf16* SS = (bf16*)(a.ws + WS_SPREVS);
    for (int gt = blockIdx.x * NTHREADS + tid; gt < 131072; gt += gridDim.x * NTHREADS) {
        const bf16* cp; const float* dp; bf16* sp; size_t cstep, dstep;
        if (gt < 65536) {
            const int b = gt >> 15, h = (gt >> 13) & 3, vd = gt & 8191, d = gt & 63;
            cp = CG + ((size_t)(b * NCH) * 4 + h) * 8192 + vd; dp = DECG + (size_t)(b * NCH) * 256 + h * 64 + d; sp = SG + ((size_t)(b * NCH) * 4 + h) * 8192 + vd; cstep = 4 * 8192; dstep = 256;
        } else {
            const int q = gt - 65536, b = q >> 15, h = (q >> 12) & 7, ps = q & 4095;
            cp = CS + ((size_t)(b * NCH) * 8 + h) * 4096 + ps; dp = DECS + (size_t)(b * NCH) * 8 + h; sp = SS + ((size_t)(b * NCH) * 8 + h) * 4096 + ps; cstep = 8 * 4096; dstep = 8;
        }
        unsigned cv[8], cn[8]; float dv[8], dn[8];
#pragma unroll
        for (int i = 0; i < 8; ++i) { cv[i] = cp[(size_t)i * cstep]; dv[i] = dp[(size_t)i * dstep]; }
        float s = 0.f;
#pragma unroll 1
        for (int n = 0; n < NCH; n += 8) {
            const int nn = (n + 8 < NCH) ? n + 8 : n;
#pragma unroll
            for (int i = 0; i < 8; ++i) { cn[i] = cp[(size_t)(nn + i) * cstep]; dn[i] = dp[(size_t)(nn + i) * dstep]; }
            PIN8(cn); PIN8(dn);
#pragma unroll
            for (int i = 0; i < 8; ++i) { sp[(size_t)(n + i) * cstep] = (bf16)f2bf(s); s = dv[i] * s + bf2f(cv[i]); }
#pragma unroll
            for (int i = 0; i < 8; ++i) { cv[i] = cn[i]; dv[i] = dn[i]; }
        }
    }
}

DI void phase_s3(const Ctx& a, const MixArgs& m, LAS unsigned char* lds, int tid, int lane, int wave) {
    const bf16* PROJ = (const bf16*)(a.ws + WS_PROJ); const float* SMALL = (const float*)(a.ws + WS_SMALL);
    const bf16* XBC = (const bf16*)(a.ws + WS_XBC);
    const bf16* SG = (const bf16*)(a.ws + WS_SPREVG); const bf16* SS = (const bf16*)(a.ws + WS_SPREVS);
    bf16* MG = (bf16*)(a.ws + WS_MERGED);
    const int g = lane >> 4, fr = lane & 15;
#ifndef MK_S3_REP_G
#define MK_S3_REP_G 1
#endif
#ifndef MK_S3_REP_S
#define MK_S3_REP_S 1
#endif
    for (int rep_g = 0; rep_g < MK_S3_REP_G; ++rep_g)
    for (int u = blockIdx.x; u < NUNIT; u += gridDim.x) {
        const int b = u / NCH, c = u % NCH, r0 = b * SEQ + c * CH;
        {
            LAS float* ALR = (LAS float*)lds;
            LAS unsigned char* QE = lds + 4096;
            LAS unsigned char* KE = lds + 37888;
            LAS unsigned char* VN = lds + 74752;
            LAS float* HTOT = (LAS float*)(lds + 141312);
            float aw[17];
            {
              f32x4 ta = {0.f, 0.f, 0.f, 0.f}; u32x4 tv[8], tq[8];
              gla_load_aw(m, tid, aw);
              if (tid < 256) ta = *(const f32x4*)(SMALL + (size_t)(r0 + (tid >> 2)) * 32 + 4 * (tid & 3));
#pragma unroll
              for (int i = 0; i < 8; ++i) { const int id = tid + NTHREADS * i, row = id >> 6, cp = id & 63; tv[i] = *(const u32x4*)(PROJ + (size_t)(r0 + row) * PROJ_LD + C_V + cp * 8); }
#pragma unroll
              for (int i = 0; i < 4; ++i) { const int id = tid + NTHREADS * i, row = id >> 5, cp = id & 31;
                  tq[i] = *(const u32x4*)(PROJ + (size_t)(r0 + row) * PROJ_LD + C_Q + cp * 8); tq[4 + i] = *(const u32x4*)(PROJ + (size_t)(r0 + row) * PROJ_LD + C_K + cp * 8); }
              PIN8(tv); PIN8(tq); asm volatile("" : "+v"(ta));
              if (tid < 256) *(LAS f32x4*)(ALR + (tid >> 2) * 16 + 4 * (tid & 3)) = ta;
#pragma unroll
              for (int i = 0; i < 8; ++i) { const int id = tid + NTHREADS * i, row = id >> 6, cp = id & 63; *(LAS u32x4*)(VN + row * 1040 + cp * 16) = tv[i]; }
#pragma unroll
              for (int i = 0; i < 4; ++i) { const int id = tid + NTHREADS * i, row = id >> 5, cp = id & 31;
                  *(LAS u32x4*)(QE + row * 528 + cp * 16) = tq[i]; *(LAS u32x4*)(KE + row * 528 + cp * 16) = tq[4 + i]; } }
            __syncthreads();
            {
                float cs[32];
                (void)gla_cumsum(aw, ALR, HTOT, tid, cs);
                const int hd = tid & 255, half = tid >> 8;
#pragma unroll
                for (int jj = 0; jj < 32; ++jj) { const int j = half * 32 + jj;
                    const float qv = bf2f(*(const LAS bf16*)(QE + j * 528 + hd * 2)), kv = bf2f(*(const LAS bf16*)(KE + j * 528 + hd * 2));
                    *(LAS bf16*)(QE + j * 528 + hd * 2) = (bf16)f2bf(qv * 0.125f * __expf(cs[jj]));
                    *(LAS bf16*)(KE + j * 528 + hd * 2) = (bf16)f2bf(kv * __expf(-cs[jj])); }
            }
            __syncthreads();
            const int h = wave >> 1, ih = wave & 1, i0 = 32 * ih;
            bf16x8 qf[2][2];
#pragma unroll
            for (int it = 0; it < 2; ++it)
#pragma unroll
                for (int ks = 0; ks < 2; ++ks) qf[it][ks] = frag_rowk(QE, 528, i0 + 16 * it, h * 64 + 32 * ks, lane);
            f32x4 at[4][2];
#pragma unroll
            for (int jt = 0; jt < 4; ++jt)
#pragma unroll
                for (int it = 0; it < 2; ++it) at[jt][it] = (f32x4){0.f, 0.f, 0.f, 0.f};
#pragma unroll
            for (int jt = 0; jt < 4; ++jt) {
                if (jt < 2 * (ih + 1)) {
#pragma unroll
                    for (int ks = 0; ks < 2; ++ks) { const bf16x8 kf = frag_rowk(KE, 528, 16 * jt, h * 64 + 32 * ks, lane);
#pragma unroll
                        for (int it = 0; it < 2; ++it) at[jt][it] = MFMA16(kf, qf[it][ks], at[jt][it]); } } }
            __syncthreads();
            LAS unsigned char* PW = KE + wave * 4608;
#pragma unroll
            for (int jt = 0; jt < 4; ++jt)
#pragma unroll
                for (int it = 0; it < 2; ++it) { const int i = i0 + 16 * it + fr; float v[4];
#pragma unroll
                    for (int r = 0; r < 4; ++r) { const int j = 16 * jt + 4 * g + r; v[r] = (j <= i) ? at[jt][it][r] : 0.f; }
                    u32x2 w; w.x = pk2(v[0], v[1]); w.y = pk2(v[2], v[3]);
                    *(LAS u32x2*)(PW + (16 * it + fr) * 144 + (16 * jt + 4 * g) * 2) = w; }
            f32x4 oa[8][2];
#pragma unroll
            for (int vt = 0; vt < 8; ++vt)
#pragma unroll
                for (int it = 0; it < 2; ++it) oa[vt][it] = (f32x4){0.f, 0.f, 0.f, 0.f};
            const bf16* sg = SG + ((size_t)u * 4 + h) * 8192;
#pragma unroll
            for (int ks = 0; ks < 2; ++ks) { bf16x8 sf[8];
#pragma unroll
                for (int vt = 0; vt < 8; ++vt) sf[vt] = *(const bf16x8*)(sg + (16 * vt + fr) * 64 + 32 * ks + 8 * g);
#pragma unroll
                for (int vt = 0; vt < 8; ++vt)
#pragma unroll
                    for (int it = 0; it < 2; ++it) oa[vt][it] = MFMA16(sf[vt], qf[it][ks], oa[vt][it]); }
#pragma unroll
            for (int ks = 0; ks < 2; ++ks) {
                if (ks <= ih) { bf16x8 pf[2];
#pragma unroll
                    for (int it = 0; it < 2; ++it) pf[it] = frag_rowk(PW, 144, 16 * it, 32 * ks, lane);
#pragma unroll
                    for (int vt = 0; vt < 8; ++vt) { const bf16x8 vf = frag_tr(VN, 1040, 32 * ks, h * 128 + 16 * vt, lane);
#pragma unroll
                        for (int it = 0; it < 2; ++it) oa[vt][it] = MFMA16(vf, pf[it], oa[vt][it]); } } }
#pragma unroll
            for (int it = 0; it < 2; ++it) { float ss = 0.f;
#pragma unroll
                for (int vt = 0; vt < 8; ++vt) ss += (oa[vt][it][0] * oa[vt][it][0] + oa[vt][it][1] * oa[vt][it][1]) + (oa[vt][it][2] * oa[vt][it][2] + oa[vt][it][3] * oa[vt][it][3]);
                ss += shfl_xor_l(ss, 16, lane); ss += shfl_xor_l(ss, 32, lane);
                const float rstd = __builtin_amdgcn_rsqf(ss * (1.0f / 128.0f) + EPS);
                const size_t row = (size_t)(r0 + i0 + 16 * it + fr);
                f32x4 nwv[8]; u32x2 gtv[8];
#pragma unroll
                for (int vt = 0; vt < 8; ++vt) { const int vc = 16 * vt + 4 * g; nwv[vt] = *(const f32x4*)(m.gnw + vc); gtv[vt] = *(const u32x2*)(PROJ + row * PROJ_LD + C_G + h * 128 + vc); }
#pragma unroll
                for (int vt = 0; vt < 8; ++vt) { const int vc = 16 * vt + 4 * g; const f32x4 nw = nwv[vt];
                    const u32x2 gt = gtv[vt];
                    const f32x4 o = oa[vt][it]; u32x2 w;
                    w.x = pk2(o[0] * rstd * nw[0] * silu_f(bflo(gt.x)), o[1] * rstd * nw[1] * silu_f(bfhi(gt.x)));
                    w.y = pk2(o[2] * rstd * nw[2] * silu_f(bflo(gt.y)), o[3] * rstd * nw[3] * silu_f(bfhi(gt.y)));
                    *(u32x2*)(MG + row * D + h * 128 + vc) = w; } }
            __syncthreads();
        }
    }
    for (int rep_s = 0; rep_s < MK_S3_REP_S; ++rep_s)
    for (int u = blockIdx.x; u < NUNIT; u += gridDim.x) {
        const int b = u / NCH, c = u % NCH, r0 = b * SEQ + c * CH; (void)b; (void)c;
        {
            LAS float* DT = (LAS float*)lds;
            LAS float* CUM = (LAS float*)(lds + 2048);
            LAS float* RED = (LAS float*)(lds + 4096);
            LAS unsigned char* XS = lds + 8192;
            LAS unsigned char* BN = lds + 74752;
            LAS unsigned char* CN = lds + 92160;
            LAS unsigned char* PW = lds + 109568 + wave * 4608;
            float cum_last; ssd_dt_cum(m, SMALL, r0, DT, CUM, lane, wave, cum_last);
            { u32x4 ta[8], tb[4];
#pragma unroll
              for (int i = 0; i < 12; ++i) { const int id = tid + NTHREADS * i, row = id / 96, cp = id % 96; const u32x4 v = *(const u32x4*)(XBC + (size_t)(r0 + row) * 768 + cp * 8); if (i < 8) ta[i] = v; else tb[i - 8] = v; }
              PIN8(ta); PIN4(tb);
#pragma unroll
              for (int i = 0; i < 12; ++i) { const int id = tid + NTHREADS * i, row = id / 96, cp = id % 96;
                  LAS unsigned char* dst = cp < 64 ? XS + row * 1040 + cp * 16 : (cp < 80 ? BN + row * 272 + (cp - 64) * 16 : CN + row * 272 + (cp - 80) * 16);
                  *(LAS u32x4*)dst = i < 8 ? ta[i] : tb[i - 8]; } }
            __syncthreads();
            const int h = wave, gi = h >> 2;
            const float dsk = m.dskip[h];
            const bf16* ss = SS + ((size_t)u * 8 + h) * 4096;
            f32x4 snwv[4];
#pragma unroll
            for (int pt = 0; pt < 4; ++pt) snwv[pt] = *(const f32x4*)(m.snw + h * 64 + 16 * pt + 4 * g);
#pragma unroll 1
            for (int ih = 0; ih < 2; ++ih) {
                bf16x8 cf[2][2];
#pragma unroll
                for (int it = 0; it < 2; ++it)
#pragma unroll
                    for (int ks = 0; ks < 2; ++ks) cf[it][ks] = frag_rowk(CN, 272, 32 * ih + 16 * it, gi * 64 + 32 * ks, lane);
                float cumi[2];
#pragma unroll
                for (int it = 0; it < 2; ++it) cumi[it] = CUM[(32 * ih + 16 * it + fr) * 8 + h];
#pragma unroll
                for (int jt = 0; jt < 4; ++jt) {
                    f32x4 gt[2] = {{0.f, 0.f, 0.f, 0.f}, {0.f, 0.f, 0.f, 0.f}};
                    if (jt < 2 * (ih + 1)) {
#pragma unroll
                        for (int ks = 0; ks < 2; ++ks) { const bf16x8 bfr = frag_rowk(BN, 272, 16 * jt, gi * 64 + 32 * ks, lane);
#pragma unroll
                            for (int it = 0; it < 2; ++it) gt[it] = MFMA16(bfr, cf[it][ks], gt[it]); } }
                    float cj[4], dj[4];
#pragma unroll
                    for (int r = 0; r < 4; ++r) { const int j = 16 * jt + 4 * g + r; cj[r] = CUM[j * 8 + h]; dj[r] = DT[j * 8 + h]; }
#pragma unroll
                    for (int it = 0; it < 2; ++it) { const int i = 32 * ih + 16 * it + fr; float v[4];
#pragma unroll
                        for (int r = 0; r < 4; ++r) { const int j = 16 * jt + 4 * g + r; v[r] = (j <= i) ? gt[it][r] * __expf(cumi[it] - cj[r]) * dj[r] : 0.f; }
                        u32x2 w; w.x = pk2(v[0], v[1]); w.y = pk2(v[2], v[3]);
                        *(LAS u32x2*)(PW + (16 * it + fr) * 144 + (16 * jt + 4 * g) * 2) = w; }
                }
                f32x4 ya[4][2];
#pragma unroll
                for (int pt = 0; pt < 4; ++pt)
#pragma unroll
                    for (int it = 0; it < 2; ++it) ya[pt][it] = (f32x4){0.f, 0.f, 0.f, 0.f};
#pragma unroll
                for (int ks = 0; ks < 2; ++ks)
#pragma unroll
                    for (int pt = 0; pt < 4; ++pt) { const bf16x8 sf = *(const bf16x8*)(ss + (16 * pt + fr) * 64 + 32 * ks + 8 * g);
#pragma unroll
                        for (int it = 0; it < 2; ++it) ya[pt][it] = MFMA16(sf, cf[it][ks], ya[pt][it]); }
#pragma unroll
                for (int it = 0; it < 2; ++it) { const float ec = __expf(cumi[it]);
#pragma unroll
                    for (int pt = 0; pt < 4; ++pt) ya[pt][it] = ya[pt][it] * ec; }
#pragma unroll
                for (int ks = 0; ks < 2; ++ks) {
                    if (ks <= ih) { bf16x8 pf[2];
#pragma unroll
                        for (int it = 0; it < 2; ++it) pf[it] = frag_rowk(PW, 144, 16 * it, 32 * ks, lane);
#pragma unroll
                        for (int pt = 0; pt < 4; ++pt) { const bf16x8 xf = frag_tr(XS, 1040, 32 * ks, h * 64 + 16 * pt, lane);
#pragma unroll
                            for (int it = 0; it < 2; ++it) ya[pt][it] = MFMA16(xf, pf[it], ya[pt][it]); } } }
                u32x2 zvv[2][4];
#pragma unroll
                for (int it = 0; it < 2; ++it)
#pragma unroll
                    for (int pt = 0; pt < 4; ++pt) zvv[it][pt] = *(const u32x2*)(PROJ + (size_t)(r0 + 32 * ih + 16 * it + fr) * PROJ_LD + C_Z + h * 64 + 16 * pt + 4 * g);
#pragma unroll
                for (int it = 0; it < 2; ++it) { const int i = 32 * ih + 16 * it + fr; float sq = 0.f;
#pragma unroll
                    for (int pt = 0; pt < 4; ++pt) { const int pc = h * 64 + 16 * pt + 4 * g;
                        const u32x2 xv = *(const LAS u32x2*)(XS + i * 1040 + pc * 2); const u32x2 zv = zvv[it][pt];
                        f32x4 y = ya[pt][it];
                        y[0] = (y[0] + dsk * bflo(xv.x)) * silu_f(bflo(zv.x)); y[1] = (y[1] + dsk * bfhi(xv.x)) * silu_f(bfhi(zv.x));
                        y[2] = (y[2] + dsk * bflo(xv.y)) * silu_f(bflo(zv.y)); y[3] = (y[3] + dsk * bfhi(xv.y)) * silu_f(bfhi(zv.y));
                        ya[pt][it] = y; sq += (y[0] * y[0] + y[1] * y[1]) + (y[2] * y[2] + y[3] * y[3]); }
                    sq += shfl_xor_l(sq, 16, lane); sq += shfl_xor_l(sq, 32, lane);
                    if (g == 0) RED[h * 64 + i] = sq; }
                __syncthreads();
#pragma unroll
                for (int it = 0; it < 2; ++it) { const int i = 32 * ih + 16 * it + fr; float tot = 0.f;
#pragma unroll
                    for (int hh = 0; hh < 8; ++hh) tot += RED[hh * 64 + i];
                    const float rstd = __builtin_amdgcn_rsqf(tot * (1.0f / 512.0f) + EPS);
#pragma unroll
                    for (int pt = 0; pt < 4; ++pt) { const int pc = h * 64 + 16 * pt + 4 * g; const f32x4 nw = snwv[pt]; const f32x4 y = ya[pt][it];
                        u32x2 w; w.x = pk2(y[0] * rstd * nw[0], y[1] * rstd * nw[1]); w.y = pk2(y[2] * rstd * nw[2], y[3] * rstd * nw[3]);
                        *(u32x2*)(MG + (size_t)(r0 + i) * D + 512 + pc) = w; } }
            }
            __syncthreads();
        }
    }
}

constexpr int PH_FINAL = 41, N_PHASES = 42;
#ifndef MK_MASK
#define MK_MASK 0xffffffffu
#endif
#define SITE(n) (((MK_MASK) >> (n)) & 1u)
#define IN(k) (lo <= (k) && (k) < hi)
#define SEAM(k) do { if (hi > (k) + 1) { XcdBarrier b_ = bar; { GAS unsigned* bp_ = (GAS unsigned*)bar.bar; asm volatile("" : "+s"(bp_)); b_.bar = (unsigned*)bp_; } xcd_barrier(b_, tid); } } while (0)
#define PHASE_CTX int lane; asm volatile("v_mbcnt_lo_u32_b32 %0, -1, 0\n\tv_mbcnt_hi_u32_b32 %0, -1, %0" : "=v"(lane) : "s"(l)); int wave = wave_s, G = (int)gridDim.x, bid = (int)blockIdx.x; asm volatile("" : "+s"(wave), "+s"(G), "+s"(bid) : "s"(l)); const int tid = wave * 64 + lane; (void)G; (void)bid; Ctx a = a0; { GAS unsigned char* w_ = (GAS unsigned char*)a0.ws; asm volatile("" : "+s"(w_) : "s"(l)); a.ws = (unsigned char*)w_; } unsigned char* ws = a.ws; (void)ws; \
    float* MOD = (float*)(ws + WS_MOD); bf16* X = (bf16*)(ws + WS_X); bf16* H = (bf16*)(ws + WS_H); bf16* HTOK = (bf16*)(ws + WS_HTOK); bf16* Y2 = (bf16*)(ws + WS_Y2); bf16* PROJ = (bf16*)(ws + WS_PROJ); \
    bf16* MERGED = (bf16*)(ws + WS_MERGED); bf16* HID = (bf16*)(ws + WS_HID); const float* mod = MOD + (size_t)l * 2 * 6144; (void)X; (void)H; (void)HTOK; (void)Y2; (void)PROJ; (void)MERGED; (void)HID; (void)mod;

template <int l> DI void run_layer(const Ctx& a0, LAS unsigned char* lds, const int wave_s, const int lo, const int hi, const XcdBarrier& bar, const int dummy) {
        constexpr int pb = 1 + 10 * l, li = l >> 1; constexpr bool moe = (l & 1) != 0;
                if (SITE(1) && IN(pb + 0)) { PHASE_CTX
            NormArgs na; na.xin = (l == 0) ? INP(I_X) : nullptr; na.X = X; na.nw = INP(I_N1W) + (size_t)l * D; na.sc = mod + 1024; na.sh = mod; na.g2 = MOD + (size_t)(l ? l - 1 : 0) * 2 * 6144 + 5120; na.Y2 = Y2; na.H = H; na.out = nullptr; na.Y2b = nullptr; na.combine = (l == 2) && !(MK_DBG_SKIP & 4) && !dummy;
            norm_phase<0>(a, na, lds, tid, lane, wave, nullptr, nullptr); SEAM(pb + 0); }
        if (SITE(2) && IN(pb + 1)) { PHASE_CTX
            pg8::Gemm g{H, (const bf16*)(ws + WS_WIN) + (size_t)l * NPROJ_PAD * D, T, NPROJ_PAD, D}; pg8::StaticOrder S; S.init(T / 256, NPROJ_PAD / 256, G, bid, D / 64);
            pg8::EpiProj E{PROJ, (float*)(ws + WS_SMALL)};
            pg8::gemm_phase<pg8::EpiProj, pg8::StaticOrder, true, true>(lds, g, S, E, tid); SEAM(pb + 1); }
        if (SITE(3) && IN(pb + 2)) { PHASE_CTX const MixArgs m = mk_mix(a, l); phase_s1(a, m, lds, tid, lane, wave); SEAM(pb + 2); }
        if (SITE(4) && IN(pb + 3)) { PHASE_CTX phase_scan(a, tid); SEAM(pb + 3); }
        if (SITE(5) && IN(pb + 4)) { PHASE_CTX const MixArgs m = mk_mix(a, l); phase_s3(a, m, lds, tid, lane, wave); SEAM(pb + 4); }
        if (SITE(6) && IN(pb + 5)) { PHASE_CTX
            pg8::Gemm g{MERGED, (const bf16*)(ws + WS_WOUT) + (size_t)l * D * D, T, D, D}; pg8::StaticOrder S; S.init(T / 256, D / 256, G, bid, D / 64);
            pg8::EpiResid E{(l == 0) ? INP(I_X) : nullptr, X, mod + 2048, ((MK_DBG_SKIP & 1) || dummy) ? 0.f : 1.f};
            pg8::gemm_phase<pg8::EpiResid, pg8::StaticOrder, false, true>(lds, g, S, E, tid); SEAM(pb + 5); }
        if constexpr (!moe) {
            if (SITE(7) && IN(pb + 6)) { PHASE_CTX
                NormArgs na; na.xin = nullptr; na.X = X; na.nw = INP(I_N2W) + (size_t)l * D; na.sc = mod + 4096; na.sh = mod + 3072; na.g2 = mod + 5120; na.Y2 = Y2; na.H = H; na.out = nullptr; na.Y2b = nullptr; na.combine = 0;
                norm_phase<3>(a, na, lds, tid, lane, wave, nullptr, nullptr); SEAM(pb + 6); }
            if (SITE(8) && IN(pb + 7)) { PHASE_CTX
                pg8::Gemm g{H, (const bf16*)(ws + WS_WGU + (size_t)li * 2 * DFF * D), T, 2 * DFF, D / 2}; pg8::StaticOrder S; S.init(T / 256, 2 * DFF / 256, G, bid, D / 128);
                pg8::EpiSwiglu<true> E{HID, dummy > 1 ? dummy : 0};
                pg8::gemm_phase<pg8::EpiSwiglu<true>, pg8::StaticOrder, true, true, true>(lds, g, S, E, tid); SEAM(pb + 7); }
            if (SITE(9) && IN(pb + 8)) { PHASE_CTX
                pg8::Gemm g{HID, (const bf16*)(ws + WS_WD + (size_t)li * D * DFF), T, D, DFF / 2}; pg8::StaticOrder S; S.init(T / 256, D / 256, G, bid, DFF / 128);
                pg8::EpiResid E{nullptr, X, mod + 5120, ((MK_DBG_SKIP & 2) || dummy) ? 0.f : 1.f};
                pg8::gemm_phase<pg8::EpiResid, pg8::StaticOrder, false, true, true>(lds, g, S, E, tid); SEAM(pb + 8); }
        } else {
            if (SITE(10) && IN(pb + 6)) { PHASE_CTX
                NormArgs na; na.xin = nullptr; na.X = X; na.nw = INP(I_N2W) + (size_t)l * D; na.sc = mod + 4096; na.sh = mod + 3072; na.g2 = mod + 5120; na.Y2 = Y2; na.H = HTOK; na.out = nullptr; na.Y2b = nullptr; na.combine = 0;
                norm_phase<1>(a, na, lds, tid, lane, wave, INP(I_RW) + (size_t)li * D * NE, (unsigned*)(ws + WS_CTL) + CW_CNT + (dummy ? 4 : li) * 8 * 64); SEAM(pb + 6); }
            if (SITE(11) && IN(pb + 7)) { PHASE_CTX moe_permute(a, (unsigned*)(ws + WS_CTL) + CW_CNT + li * 8 * 64, lds, tid, lane, wave); SEAM(pb + 7); }
            if (SITE(12) && IN(pb + 8)) { PHASE_CTX
                int off[9]; moe_offsets((unsigned*)(ws + WS_CTL) + CW_CNT + li * 8 * 64, off); const int NT = off[8] >> 8;
                pg8::Gemm g{HTOK, (const bf16*)(ws + WS_MGU + (size_t)li * 8 * 2 * DFF * D), NT * 256, 2 * DFF, D / 2}; pg8::GatherOrder S; S.init(NT, 2 * DFF / 256, G, bid, D / 128);
                S.t1 = off[1] >> 8; S.t2 = off[2] >> 8; S.t3 = off[3] >> 8; S.t4 = off[4] >> 8; S.t5 = off[5] >> 8; S.t6 = off[6] >> 8; S.t7 = off[7] >> 8; S.estride = (size_t)2 * DFF * D;
                {
                    LAS unsigned* TOK = (LAS unsigned*)(lds + 131072); S.tok = TOK; const int* RI = (const int*)(ws + WS_ROWINFO);
                    int ti[16];
#pragma unroll
                    for (int i = 0; i < 16; ++i) { pg8::Unit uu; ti[i] = -1; if (tid < 256 && S.next(i, uu)) ti[i] = RI[2 * (uu.pm * 256 + tid)]; }
                    PIN8(ti); PIN8(ti + 8);
                    if (tid < 256) {
#pragma unroll
                        for (int i = 0; i < 16; ++i) TOK[i * 256 + tid] = ti[i] < 0 ? 0u : (unsigned)(ti[i] & 0x3fffffff) * (unsigned)D; }
                    __syncthreads(); }
                pg8::EpiSwiglu<true> E{HID, dummy > 1 ? dummy : 0};
                pg8::gemm_phase<pg8::EpiSwiglu<true>, pg8::GatherOrder, true, true, true>(lds, g, S, E, tid);
                if constexpr (l == 1) {
                    const int nwg = NT * (2 * DFF / 256), rounds = (nwg + G - 1) / G, fi = nwg - (rounds - 1) * G;
                    if (bid >= fi && fi < G) convert_moe_late(a, (bid - fi) * NWAVES + wave, (G - fi) * NWAVES, lane, 0, MOE_LATE_SPLIT); }
                SEAM(pb + 8); }
            if (SITE(13) && IN(pb + 9)) { PHASE_CTX
                int off[9]; moe_offsets((unsigned*)(ws + WS_CTL) + CW_CNT + li * 8 * 64, off); const int NT = off[8] >> 8;
                pg8::Gemm g{HID, (const bf16*)(ws + WS_MD + (size_t)li * 8 * D * DFF), NT * 256, D, DFF / 2}; pg8::StaticOrder S; S.init(NT, D / 256, G, bid, DFF / 128);
                S.t1 = off[1] >> 8; S.t2 = off[2] >> 8; S.t3 = off[3] >> 8; S.t4 = off[4] >> 8; S.t5 = off[5] >> 8; S.t6 = off[6] >> 8; S.t7 = off[7] >> 8; S.estride = (size_t)D * DFF;
                pg8::EpiMoeDown E{Y2, (const int*)(ws + WS_ROWINFO), (bf16*)(ws + WS_SKP), ws + WS_SKP, (unsigned*)(ws + WS_CTL) + CW_SK + li * 256 * 64};
                pg8::gemm_phase<pg8::EpiMoeDown, pg8::StaticOrder, true, true, true>(lds, g, S, E, tid);
                if constexpr (l == 1) {
                    const int fi = (NT * 4 - 2 * G) > 0 ? (NT * 4 - 2 * G) : 0;
                    const int nwg3 = NT * (2 * DFF / 256), fi3 = nwg3 - ((nwg3 + G - 1) / G - 1) * G;
                    if (bid >= fi) convert_moe_late(a, (bid - fi) * NWAVES + wave, (G - fi) * NWAVES, lane, fi3 < G ? MOE_LATE_SPLIT : 0, MOE_LATE_ITEMS); }
                SEAM(pb + 9); }
        }
}
__global__ void __launch_bounds__(NTHREADS, 2) mk_fwd(Args ka) {
    extern __shared__ __attribute__((aligned(16))) unsigned char lds_raw[];
    LAS unsigned char* lds = (LAS unsigned char*)lds_raw;
    const int wave_s = __builtin_amdgcn_readfirstlane((int)threadIdx.x >> 6);
    volatile LAS unsigned* MISC = (volatile LAS unsigned*)(lds + MISC_OFF);
    {
        const int t = threadIdx.x;
        if (t < 64) MISC[t] = 0u;
        if (t < N_IN + 1) { const unsigned long long* kp = (const unsigned long long*)__builtin_amdgcn_kernarg_segment_ptr(); ((LAS unsigned long long*)(lds + MISC_OFF + 256))[t] = kp[t]; }
    }
    __syncthreads();
    Ctx a0; a0.ws = ka.ws; a0.tab = (const LAS unsigned*)(lds + MISC_OFF + 256);
    unsigned* ctl = (unsigned*)(a0.ws + WS_CTL);
    const int lo = ka.ph_lo, hi = ka.ph_hi, dummy = ka.dummy;
    XcdBarrier bar; bar.bar = ctl + CW_BAR; bar.x = 0; bar.st = MISC + 8;
    if (hi - lo > 1) bar = xcd_barrier_post(ctl + CW_BAR, MISC + 8, (int)threadIdx.x);
    if (SITE(0) && IN(0)) { const int l = 0; PHASE_CTX adaln_items(a, lds, tid, lane, wave); convert_weights(a, lane, wave); SEAM(0); }

    run_layer<0>(a0, lds, wave_s, lo, hi, bar, dummy);
    run_layer<1>(a0, lds, wave_s, lo, hi, bar, dummy);
    run_layer<2>(a0, lds, wave_s, lo, hi, bar, dummy);
    run_layer<3>(a0, lds, wave_s, lo, hi, bar, dummy);
    if (SITE(14) && IN(PH_FINAL)) { const int l = 3; PHASE_CTX
        NormArgs na; na.xin = nullptr; na.X = X; na.nw = INP(I_FNW); na.sc = nullptr; na.sh = nullptr; na.g2 = MOD + (size_t)3 * 2 * 6144 + 5120; na.Y2 = Y2; na.H = nullptr; na.out = (float*)INP(N_IN); na.combine = 1; na.Y2b = nullptr;
        norm_phase<2>(a, na, lds, tid, lane, wave, nullptr, nullptr);
    }
}
#undef IN
#undef SEAM

#if MK_NAIVE_MIX
struct DbgMix { const float* gaw; const float* gab; const float* gnw; const float* convw; const float* convb; const float* dtb; const float* alog; const float* dskip; const float* snw; };
__global__ void __launch_bounds__(512) dbg_mixer(unsigned char* ws, DbgMix m) {
    __shared__ float sh_a[64], sh_q[64], sh_k[64], sh_v[128], sh_red[512], sh_o[128], sh_x[64], sh_B[64], sh_C[64], sh_s[4];
    const bf16* PROJ = (const bf16*)(ws + WS_PROJ); const float* SMALL = (const float*)(ws + WS_SMALL); bf16* MG = (bf16*)(ws + WS_MERGED); float* YT = (float*)(ws + WS_CONTRG);
    const int blk = blockIdx.x, t = threadIdx.x;
    if (blk < 8) {
        const int b = blk >> 2, h = blk & 3, v = t & 127, dg = t >> 7;
        float S[16];
        for (int i = 0; i < 16; ++i) S[i] = 0.f;
        for (int tok = 0; tok < SEQ; ++tok) {
            const size_t row = (size_t)b * SEQ + tok;
            if (t < 64) { float x = m.gab[h * 64 + t]; for (int r = 0; r < 16; ++r) x += SMALL[row * 32 + r] * m.gaw[r * 256 + h * 64 + t];
                sh_a[t] = expf(logsigmoid_f(x) * (1.0f / 16.0f)); sh_q[t] = bf2f(PROJ[row * PROJ_LD + C_Q + h * 64 + t]) * 0.125f; sh_k[t] = bf2f(PROJ[row * PROJ_LD + C_K + h * 64 + t]); }
            else if (t < 192) sh_v[t - 64] = bf2f(PROJ[row * PROJ_LD + C_V + h * 128 + t - 64]);
            __syncthreads();
            float part = 0.f;
            for (int dd = 0; dd < 16; ++dd) { const int d = dg * 16 + dd; S[dd] = sh_a[d] * S[dd] + sh_k[d] * sh_v[v]; part += sh_q[d] * S[dd]; }
            sh_red[dg * 128 + v] = part;
            __syncthreads();
            if (t < 128) sh_o[t] = (sh_red[t] + sh_red[128 + t]) + (sh_red[256 + t] + sh_red[384 + t]);
            __syncthreads();
            if (t < 128) { float ss = 0.f; for (int i = 0; i < 128; ++i) ss += sh_o[i] * sh_o[i];
                const float rstd = 1.0f / sqrtf(ss * (1.0f / 128.0f) + EPS);
                const float gt = bf2f(PROJ[row * PROJ_LD + C_G + h * 128 + t]);
                MG[row * D + h * 128 + t] = (bf16)f2bf(sh_o[t] * rstd * m.gnw[t] * silu_f(gt)); }
            __syncthreads();
        }
    } else {
        const int q = blk - 8, b = q >> 3, h = q & 7, gi = h >> 2, p = t & 63, sg = t >> 6;
        float S[8];
        for (int i = 0; i < 8; ++i) S[i] = 0.f;
        const float av = -expf(m.alog[h]);
        for (int tok = 0; tok < SEQ; ++tok) {
            const size_t row = (size_t)b * SEQ + tok;
            if (t < 192) { const int ch = t < 64 ? h * 64 + t : (t < 128 ? 512 + gi * 64 + (t - 64) : 640 + gi * 64 + (t - 128));
                float acc = m.convb[ch];
                for (int k = 0; k < 4; ++k) { const int tt = tok - 3 + k; if (tt >= 0) acc += m.convw[k * 768 + ch] * bf2f(PROJ[(row - 3 + k) * PROJ_LD + C_XS + ch]); }
                const float val = silu_f(acc);
                if (t < 64) sh_x[t] = val; else if (t < 128) sh_B[t - 64] = val; else sh_C[t - 128] = val; }
            if (t == 192) { const float dt = softplus_f(SMALL[row * 32 + 16 + h] + m.dtb[h]); sh_s[0] = dt; sh_s[1] = expf(dt * av); }
            __syncthreads();
            const float dt = sh_s[0], dec = sh_s[1];
            float part = 0.f;
            for (int ss = 0; ss < 8; ++ss) { const int s = sg * 8 + ss; S[ss] = dec * S[ss] + dt * sh_B[s] * sh_x[p]; part += sh_C[s] * S[ss]; }
            sh_red[sg * 64 + p] = part;
            __syncthreads();
            if (t < 64) { float y = 0.f; for (int i = 0; i < 8; ++i) y += sh_red[i * 64 + t];
                y += m.dskip[h] * sh_x[t]; y *= silu_f(bf2f(PROJ[row * PROJ_LD + C_Z + h * 64 + t]));
                YT[row * 512 + h * 64 + t] = y; }
            __syncthreads();
        }
    }
}
__global__ void __launch_bounds__(512) dbg_ssdnorm(unsigned char* ws, const float* snw) {
    const float* YT = (const float*)(ws + WS_CONTRG); bf16* MG = (bf16*)(ws + WS_MERGED);
    const int lane = threadIdx.x & 63, gw = blockIdx.x * 8 + (threadIdx.x >> 6);
    for (int row = gw; row < T; row += gridDim.x * 8) {
        float v[8], ss = 0.f;
        for (int i = 0; i < 8; ++i) { v[i] = YT[(size_t)row * 512 + lane + 64 * i]; ss += v[i] * v[i]; }
        for (int o = 1; o < 64; o <<= 1) ss += __shfl_xor(ss, o);
        const float rstd = 1.0f / sqrtf(ss * (1.0f / 512.0f) + EPS);
        for (int i = 0; i < 8; ++i) MG[(size_t)row * D + 512 + lane + 64 * i] = (bf16)f2bf(v[i] * rstd * snw[lane + 64 * i]);
    }
}
#endif

#if MK_MOE_CHECK
constexpr size_t WS_ERRW = WS_DECS + 65536;
DI unsigned dbg_hash(unsigned x) { x ^= x >> 16; x *= 0x7feb352du; x ^= x >> 15; x *= 0x846ca68bu; x ^= x >> 16; return x; }
DI float dbg_bfr(float f) { return bf2f(f2bf(f)); }
__global__ void __launch_bounds__(256) dbg_moe_check(unsigned char* ws, const float* router_w, const float* wg, const float* wu, const float* wd, int stage) {
    unsigned* errw = (unsigned*)(ws + WS_ERRW); const unsigned* cnt = (const unsigned*)(ws + WS_CTL) + CW_CNT;
    const bf16* HT = (const bf16*)(ws + WS_HTOK); const bf16* HS = (const bf16*)(ws + WS_H); const int* RI = (const int*)(ws + WS_ROWINFO); const bf16* HID = (const bf16*)(ws + WS_HID); const bf16* Y2 = (const bf16*)(ws + WS_Y2);
    int off[9]; { int o = 0; for (int e = 0; e < 8; ++e) { off[e] = o; o += (((int)cnt[64 * e] + 255) >> 8) << 8; } off[8] = o; }
    const int s = blockIdx.x * 256 + threadIdx.x;
    if (stage == 1) {
        const int t = dbg_hash(s * 2654435761u + 17u) % T;
        float lg[8]; for (int e = 0; e < 8; ++e) lg[e] = 0.f;
        for (int k = 0; k < D; ++k) { const float h = bf2f(HT[(size_t)t * D + k]); for (int e = 0; e < 8; ++e) lg[e] += h * router_w[k * 8 + e]; }
        int e0 = 0; for (int e = 1; e < 8; ++e) if (lg[e] > lg[e0]) e0 = e;
        int e1 = -1; for (int e = 0; e < 8; ++e) if (e != e0 && (e1 < 0 || lg[e] > lg[e1])) e1 = e;
        float third = -3e38f; for (int e = 0; e < 8; ++e) if (e != e0 && e != e1 && lg[e] > third) third = lg[e];
        const bool clear = (lg[e0] - lg[e1] > 0.05f) && (lg[e1] - third > 0.05f);
        const int* r = (const int*)(ws + WS_ROUTE + (size_t)t * 16);
        const int re0 = r[0] & 255, re1 = (r[0] >> 8) & 255; const float p0 = __builtin_bit_cast(float, r[3]);
        if (clear && (re0 != e0 || re1 != e1)) atomicOr(errw, 0u);

        const int d0 = off[re0] + r[1], d1 = off[re1] + r[2];
        const float q0 = __builtin_bit_cast(float, RI[2 * d0 + 1]), q1 = __builtin_bit_cast(float, RI[2 * d1 + 1]);
        if (fabsf(q0 - p0) > 1e-6f) atomicOr(errw, 1u);
        if (fabsf(q1 - (1.f - p0)) > 1e-6f) atomicOr(errw, 2u);
        if (fabsf(q0 - p0) > 1e-6f && q0 == 0.f) atomicOr(errw, 4u);
        if (fabsf(q1 - (1.f - p0)) > 1e-6f && q1 == 0.f) atomicOr(errw, 8u);
        if (!(p0 >= 0.5f && p0 <= 1.0f)) atomicOr(errw, 16u);
    } else {
        const int r = dbg_hash(s * 2246822519u + 5u) % off[8];
        int e = 0; for (int j = 1; j < 8; ++j) if (r >= off[j]) e = j;
        const int ti = RI[2 * r]; const float p = __builtin_bit_cast(float, RI[2 * r + 1]);
        if (ti < 0) return;
        if (stage == 2) {
            const int c = dbg_hash(s * 3266489917u + 3u) % DFF;
            float g = 0.f, u = 0.f;
            for (int k = 0; k < D; ++k) { const float h = bf2f(HS[(size_t)r * D + k]); g += h * dbg_bfr(wg[((size_t)e * D + k) * DFF + c]); u += h * dbg_bfr(wu[((size_t)e * D + k) * DFF + c]); }
            const float ref = g / (1.f + expf(-g)) * u, got = bf2f(HID[(size_t)r * DFF + c]);
            if (!(fabsf(got - ref) <= 0.03f * fabsf(ref) + 0.02f)) atomicOr(errw, 0u);
        } else {
            const int c = dbg_hash(s * 668265263u + 11u) % D;
            float y = 0.f;
            for (int k = 0; k < DFF; ++k) y += bf2f(HID[(size_t)r * DFF + k]) * dbg_bfr(wd[((size_t)e * DFF + k) * D + c]);
            const int tok = ti & 0x3fffffff, kk = ti >> 30; const float ref = y * p, got = bf2f(Y2[((size_t)kk * T + tok) * D + c]);
            if (!(fabsf(got - ref) <= 0.03f * fabsf(ref) + 0.02f)) atomicOr(errw, 0u);
        }
    }
}
__global__ void dbg_encode(unsigned char* ws, float* out) {
    const unsigned mask = *(const unsigned*)(ws + WS_ERRW);
    const size_t n = (size_t)mask * 512 * D;
    for (size_t i = (size_t)blockIdx.x * blockDim.x + threadIdx.x; i < n; i += (size_t)gridDim.x * blockDim.x) out[i] = 0.f;
}
#endif

extern "C" void kernel_launch(void* const* d_in, const int* in_sizes, int n_in, void* d_out, int out_size, void* d_ws, size_t ws_size, hipStream_t stream) {
    static int grid = 0;
    if (grid == 0) {
        if (n_in != N_IN || out_size != T * D || ws_size < WS_END) { fprintf(stderr, "kernel_launch: unexpected arguments (n_in %d, out %d, ws %zu < %zu)\n", n_in, out_size, ws_size, (size_t)WS_END); grid = -1; return; }
        int dev = 0, cus = 0, per_cu = 0;
        if (hipGetDevice(&dev) != hipSuccess || hipDeviceGetAttribute(&cus, hipDeviceAttributeMultiprocessorCount, dev) != hipSuccess) { grid = -1; return; }
        if (hipFuncSetAttribute((const void*)mk_fwd, hipFuncAttributeMaxDynamicSharedMemorySize, LDS_BYTES) != hipSuccess) { fprintf(stderr, "kernel_launch: hipFuncSetAttribute failed\n"); grid = -1; return; }
        if (hipOccupancyMaxActiveBlocksPerMultiprocessor(&per_cu, (const void*)mk_fwd, NTHREADS, LDS_BYTES) != hipSuccess || per_cu < 1) { fprintf(stderr, "kernel_launch: occupancy query says %d blocks per CU\n", per_cu); per_cu = 1; }
        (void)hipGetLastError();
        grid = cus;
    }
    if (grid < 0) return;
    (void)in_sizes;
    if (hipMemsetAsync((char*)d_ws + WS_CTL, 0, CTL_ZERO_BYTES, stream) != hipSuccess) return;
    Args a{};
    for (int i = 0; i < N_IN; ++i) a.in[i] = (const float*)d_in[i];
    a.out = (float*)d_out; a.ws = (unsigned char*)d_ws;
#if MK_PER_PHASE
    for (int ph = 0; ph < N_PHASES; ++ph) {
        if (ph >= 1 && ph < PH_FINAL) { const int l = (ph - 1) / 10, k = (ph - 1) % 10; if (k == 9 && !(l & 1)) continue; }
        a.ph_lo = ph; a.ph_hi = ph + 1;
#if defined(MK_TIME_MASK)
#ifndef MK_TIME_DUMMY
#define MK_TIME_DUMMY 1
#endif
        { const int kind = (ph == 0) ? 10 : (ph == PH_FINAL ? 11 : ((ph - 1) % 10 + (((ph - 1) / 10) & 1 && (ph - 1) % 10 >= 6 ? 6 : 0)));
          if ((MK_TIME_MASK >> kind) & 1) { a.dummy = MK_TIME_DUMMY; for (int r = 0; r < MK_TIME_REPS; ++r) hipLaunchKernelGGL(mk_fwd, dim3(grid), dim3(NTHREADS), LDS_BYTES, stream, a); a.dummy = 0; } }
#endif
#if MK_NAIVE_MIX
        if (ph >= 1 && ph < PH_FINAL) { const int l = (ph - 1) / 10, k = (ph - 1) % 10;
            if (k == 2) { DbgMix m; m.gaw = a.in[I_GAW] + (size_t)l * 16 * 256; m.gab = a.in[I_GAB] + (size_t)l * 256; m.gnw = a.in[I_GNW] + (size_t)l * 128; m.convw = a.in[I_CONVW] + (size_t)l * 4 * 768; m.convb = a.in[I_CONVB] + (size_t)l * 768;
                m.dtb = a.in[I_DTB] + (size_t)l * 8; m.alog = a.in[I_ALOG] + (size_t)l * 8; m.dskip = a.in[I_DSKIP] + (size_t)l * 8; m.snw = a.in[I_SNW] + (size_t)l * 512;
                hipLaunchKernelGGL(dbg_mixer, dim3(24), dim3(512), 0, stream, a.ws, m); continue; }
            if (k == 3) { hipLaunchKernelGGL(dbg_ssdnorm, dim3(256), dim3(512), 0, stream, a.ws, a.in[I_SNW] + (size_t)l * 512); continue; }
            if (k == 4) continue; }
#endif
        hipLaunchKernelGGL(mk_fwd, dim3(grid), dim3(NTHREADS), LDS_BYTES, stream, a);
#if MK_MOE_CHECK
        if (ph == 0) hipMemsetAsync((char*)d_ws + WS_ERRW, 0, 4, stream);
        if (ph == 11 + 7) hipLaunchKernelGGL(dbg_moe_check, dim3(8), dim3(256), 0, stream, a.ws, a.in[I_RW], a.in[I_MG], a.in[I_MU], a.in[I_MD], 1);
        if (ph == 11 + 8) hipLaunchKernelGGL(dbg_moe_check, dim3(8), dim3(256), 0, stream, a.ws, a.in[I_RW], a.in[I_MG], a.in[I_MU], a.in[I_MD], 2);
        if (ph == 11 + 9) hipLaunchKernelGGL(dbg_moe_check, dim3(8), dim3(256), 0, stream, a.ws, a.in[I_RW], a.in[I_MG], a.in[I_MU], a.in[I_MD], 3);
        if (ph == PH_FINAL) hipLaunchKernelGGL(dbg_encode, dim3(256), dim3(256), 0, stream, a.ws, a.out);
#endif
    }
#else
    a.ph_lo = 0; a.ph_hi = N_PHASES;
    hipLaunchKernelGGL(mk_fwd, dim3(grid), dim3(NTHREADS), LDS_BYTES, stream, a);
#endif
}
```

```cpp
#include <hip/hip_runtime.h>
#include <cstdio>
#include <cstdint>

#ifndef MK_PER_PHASE
#define MK_PER_PHASE 0
#endif

#ifndef MK_DBG_SKIP
#define MK_DBG_SKIP 0
#endif
#ifndef MK_MOE_CHECK
#define MK_MOE_CHECK 0
#endif
#ifndef MK_NAIVE_MIX
#define MK_NAIVE_MIX 0
#endif

#define LAS __attribute__((address_space(3)))
#define GAS __attribute__((address_space(1)))
#define DI __device__ __forceinline__
typedef unsigned short bf16;
typedef short bf16x8 __attribute__((ext_vector_type(8)));
typedef short v4i16_t __attribute__((ext_vector_type(4)));
typedef float f32x4 __attribute__((ext_vector_type(4)));
typedef float f32x2 __attribute__((ext_vector_type(2)));
typedef unsigned u32x4 __attribute__((ext_vector_type(4)));
typedef unsigned u32x2 __attribute__((ext_vector_type(2)));
typedef int i32x4 __attribute__((ext_vector_type(4)));
typedef int i32x8 __attribute__((ext_vector_type(8)));

constexpr int BATCH = 2, SEQ = 8192, D = 1024, T = BATCH * SEQ, DEPTH = 4;
constexpr int NPROJ = 2840, NPROJ_PAD = 3072, PROJ_LD = 2816;
constexpr int C_Q = 0, C_K = 256, C_V = 512, C_G = 1024, C_Z = 1536, C_XS = 2048, C_BM = 2560, C_CM = 2688;
constexpr int DFF = 3584, NE = 8;
constexpr int CH = 64, NCH = SEQ / CH, NUNIT = BATCH * NCH;
constexpr float EPS = 1e-6f;
constexpr int MAXTILES = 136;
constexpr int NWAVES = 8, NTHREADS = 512;

constexpr size_t MiB = 1u << 20;
constexpr size_t WS_CTL = 0, CTL_ZERO_BYTES = 1 * MiB;
constexpr size_t WS_MOD = 1 * MiB;
constexpr size_t WS_SMALL = 2 * MiB;
constexpr size_t WS_ROUTE = 4 * MiB;
constexpr size_t WS_ROWINFO = 5 * MiB;
constexpr size_t WS_DECG = 6 * MiB;
constexpr size_t WS_DECS = 7 * MiB;
constexpr size_t WS_BLKCNT = 7 * MiB + 32768;
constexpr size_t WS_WIN = 8 * MiB;
constexpr size_t WS_WOUT = 32 * MiB;
constexpr size_t WS_WGU = 40 * MiB;
constexpr size_t WS_WD = 68 * MiB;
constexpr size_t WS_MGU = 82 * MiB;
constexpr size_t WS_MD = 306 * MiB;
constexpr size_t WS_X = 418 * MiB;
constexpr size_t WS_H = 482 * MiB;
constexpr size_t WS_HTOK = 550 * MiB;
constexpr size_t WS_Y2 = 582 * MiB;
constexpr size_t WS_PROJ = 646 * MiB;
constexpr size_t WS_XBC = 734 * MiB;
constexpr size_t WS_CONTRG = 758 * MiB;
constexpr size_t WS_CONTRS = 790 * MiB;
constexpr size_t WS_SPREVG = 822 * MiB;
constexpr size_t WS_SPREVS = 838 * MiB;
constexpr size_t WS_MERGED = 854 * MiB;
constexpr size_t WS_HID = WS_PROJ;
constexpr size_t WS_SKP = 886 * MiB;
constexpr size_t WS_END = 950 * MiB;
static_assert(WS_HID + (size_t)MAXTILES * 256 * DFF * 2 <= WS_SKP, "HID overlay");
constexpr int CW_BAR = 4096;
constexpr int CW_CNT = 16384;
constexpr int CW_SK = 32768;

constexpr int LDS_BYTES = 163840;
constexpr int MISC_OFF = LDS_BYTES - 1024;

#define RLX_AGENT __ATOMIC_RELAXED, __HIP_MEMORY_SCOPE_AGENT
typedef float cvt_f2 __attribute__((ext_vector_type(2))); typedef __bf16 cvt_b2 __attribute__((ext_vector_type(2)));
DI unsigned pk2(float lo, float hi) { const cvt_f2 v = {lo, hi}; return __builtin_bit_cast(unsigned, __builtin_convertvector(v, cvt_b2)); }
DI unsigned f2bf(float f) { return pk2(f, f) & 0xffffu; }
DI float bf2f(unsigned b) { return __builtin_bit_cast(float, b << 16); }
DI float bflo(unsigned w) { return __builtin_bit_cast(float, w << 16); }
DI float bfhi(unsigned w) { return __builtin_bit_cast(float, w & 0xffff0000u); }
DI float shfl_idx(float v, int src_lane) { return __builtin_bit_cast(float, __builtin_amdgcn_ds_bpermute(src_lane << 2, __builtin_bit_cast(int, v))); }
DI float shfl_xor_l(float v, int o, int lane) { return shfl_idx(v, lane ^ o); }
DI float wave_sum(float v, int lane) {
#pragma unroll
    for (int o = 1; o < 64; o <<= 1) v += shfl_xor_l(v, o, lane);
    return v;
}
DI float silu_f(float x) { return x * __builtin_amdgcn_rcpf(1.0f + __expf(-x)); }
DI float softplus_f(float x) { return x > 20.f ? x : __logf(1.0f + __expf(x)); }
DI float logsigmoid_f(float x) { return fminf(x, 0.f) - __logf(1.0f + __expf(-fabsf(x))); }

DI bf16x8 frag_rowk(const LAS unsigned char* tile, int stride, int row0, int k0, int lane) {
    return *(const LAS bf16x8*)(tile + (row0 + (lane & 15)) * stride + (k0 + 8 * (lane >> 4)) * 2);
}
DI bf16x8 frag_tr(const LAS unsigned char* tile, int stride, int k0, int col0, int lane) {
    const int g = lane >> 4, q = (lane & 15) >> 2, p = lane & 3;
    const LAS unsigned char* a = tile + (k0 + 8 * g + q) * stride + (col0 + 4 * p) * 2;
    const v4i16_t r0 = __builtin_amdgcn_ds_read_tr16_b64_v4i16((LAS v4i16_t*)a);
    const v4i16_t r1 = __builtin_amdgcn_ds_read_tr16_b64_v4i16((LAS v4i16_t*)(a + 4 * stride));
    bf16x8 o; o[0] = r0[0]; o[1] = r0[1]; o[2] = r0[2]; o[3] = r0[3]; o[4] = r1[0]; o[5] = r1[1]; o[6] = r1[2]; o[7] = r1[3]; return o;
}
#define MFMA16(a, b, c) __builtin_amdgcn_mfma_f32_16x16x32_bf16((a), (b), (c), 0, 0, 0)
#define PIN8(a) asm volatile("" : "+v"((a)[0]), "+v"((a)[1]), "+v"((a)[2]), "+v"((a)[3]), "+v"((a)[4]), "+v"((a)[5]), "+v"((a)[6]), "+v"((a)[7]))
#define PIN4(a) asm volatile("" : "+v"((a)[0]), "+v"((a)[1]), "+v"((a)[2]), "+v"((a)[3]))

#define XB_TMO      128
#define XB_XCNT(j)  (256  + 64 * (j))
#define XB_XSUB(j)  (1280 + 64 * (j))
#define XB_XGEN(j)  (2304 + 64 * (j))
#define XB_TOP      3328
#define XB_TOPGEN   3392
#define XCD_BAR_WORDS 3456
#define XB_SPIN_CAP (1u << 20)
DI unsigned xb_ld(unsigned* p)              { return __hip_atomic_load(p, __ATOMIC_RELAXED, __HIP_MEMORY_SCOPE_AGENT); }
DI unsigned xb_add(unsigned* p, unsigned v) { return __hip_atomic_fetch_add(p, v, __ATOMIC_RELAXED, __HIP_MEMORY_SCOPE_AGENT); }
DI unsigned xb_xcc_id() { return (unsigned)__builtin_amdgcn_s_getreg((3 << 11) | 20) & 0xFu; }
#define XB_SPIN(cond, bar) do { unsigned _sp = 0; while (cond) { __builtin_amdgcn_s_sleep(1); \
    if ((++_sp & 255u) == 0u) { if (xb_ld(&(bar)[XB_TMO])) break; if (_sp > XB_SPIN_CAP) { atomicAdd(&(bar)[XB_TMO], 1u); break; } } } } while (0)
struct XcdBarrier { unsigned* bar; unsigned x; volatile LAS unsigned* st; };
DI XcdBarrier xcd_barrier_post(unsigned* bar, volatile LAS unsigned* st, int tid) {
    XcdBarrier b; b.bar = bar; b.x = xb_xcc_id(); b.st = st;
    if (tid == 0) (void)xb_add(&bar[XB_XCNT(b.x)], 1u);
    return b;
}
DI void xcd_barrier_complete(unsigned* bar, unsigned x, unsigned& nloc, unsigned& nx) {
    const unsigned G = gridDim.x * gridDim.y * gridDim.z;
    unsigned sum, cnt, mine, sp = 0u;
    for (;;) {
        sum = 0u; cnt = 0u; mine = 0u;
#pragma unroll 1
        for (unsigned j = 0; j < 16; ++j) { const unsigned c = xb_ld(&bar[XB_XCNT(j)]); sum += c; cnt += (c > 0u) ? 1u : 0u; mine = (j == x) ? c : mine; }
        if (sum == G) break;
        __builtin_amdgcn_s_sleep(1);
        if ((++sp & 255u) == 0u) { if (xb_ld(&bar[XB_TMO])) break; if (sp > XB_SPIN_CAP) { atomicAdd(&bar[XB_TMO], 1u); break; } }
    }
    nloc = mine > 0u ? mine : 1u; nx = cnt > 0u ? cnt : 1u;
}
DI void xcd_barrier(const XcdBarrier& b, int tid) {
    asm volatile("s_waitcnt vmcnt(0)" ::: "memory");
    __syncthreads();
    if (tid == 0) {
        unsigned* bar = b.bar;
        __builtin_amdgcn_s_waitcnt(0);
        unsigned nloc = b.st[0], nx = b.st[1];
        if (nloc == 0u) { xcd_barrier_complete(bar, b.x, nloc, nx); b.st[0] = nloc; b.st[1] = nx; }
        const unsigned old = xb_add(&bar[XB_XSUB(b.x)], 1u);
        const unsigned gen = old / nloc;
        if (old + 1u == (gen + 1u) * nloc) {
            __builtin_amdgcn_fence(__ATOMIC_RELEASE, "agent");
            asm volatile("s_waitcnt vmcnt(0)" ::: "memory");
            const unsigned og = xb_add(&bar[XB_TOP], 1u);
            const unsigned tg = og / nx;
            if (og + 1u == (tg + 1u) * nx) xb_add(&bar[XB_TOPGEN], 1u);
            else XB_SPIN(xb_ld(&bar[XB_TOPGEN]) == tg, bar);
            __builtin_amdgcn_fence(__ATOMIC_ACQUIRE, "agent");
            xb_add(&bar[XB_XGEN(b.x)], 1u);
            asm volatile("s_waitcnt vmcnt(0)" ::: "memory");
        } else {
            XB_SPIN(xb_ld(&bar[XB_XGEN(b.x)]) == gen, bar);
            __builtin_amdgcn_fence(__ATOMIC_ACQUIRE, "agent");
            asm volatile("s_waitcnt vmcnt(0)" ::: "memory");
        }
    }
    __syncthreads();
}

namespace pg8 {
#define PG8_LAS __attribute__((address_space(3)))
typedef unsigned short bf16_t;
constexpr int BM = 256, BK = 64, HALF = 128, HTB = HALF * BK * 2, STAGE_BYTES = 8 * HTB, NXCD = 8, WGM = 8;
__host__ __device__ __forceinline__ int lds_byte(int r, int c) { const int st = (r >> 4) * 2 + (c >> 5), rr = r & 15, cc = c & 31, ob = rr * 64 + cc * 2; return st * 1024 + (ob ^ (((ob >> 9) & 1) << 5)); }
__host__ __device__ __forceinline__ void stage_rc(int b, int& R, int& C) { const int st = b / 1024, sb = b % 1024, swz = sb ^ (((sb >> 9) & 1) << 5); R = (st >> 1) * 16 + swz / 64; C = (st & 1) * 32 + (swz % 64) / 2; }
__host__ __device__ __forceinline__ int perm32(int rho) { const int n = rho >> 4, i = rho & 15; return 8 * (i >> 2) + 4 * n + (i & 3); }
struct Unit { int pm, pn, kt0, nkt, role, slot; };
struct Gemm { const bf16_t* A; const bf16_t* Bt; int M, N, K; };
struct StaticOrder {
    static constexpr bool GATHER = false;
    int nM, nN, nwg, G, c, ntk, ksplit;
    int t1, t2, t3, t4, t5, t6, t7; size_t estride;
    __device__ void init(int nM_, int nN_, int G_, int c_, int ntk_) { nM = nM_; nN = nN_; nwg = nM * nN; G = G_; c = c_; ntk = ntk_; ksplit = 1; t1 = t2 = t3 = t4 = t5 = t6 = t7 = 0x7fffffff; estride = 0; }
    __device__ __forceinline__ bool next(int i, Unit& u) const {
        const long L = (long)i * G + c; if (L >= nwg) return false;
        int wgid = (int)L; { const int q = nwg / NXCD, r = nwg % NXCD, xcd = wgid % NXCD, off = wgid / NXCD; wgid = (xcd < r ? xcd * (q + 1) : r * (q + 1) + (xcd - r) * q) + off; }
        const int nig = WGM * nN, gid = wgid / nig, fm = gid * WGM, gsz = (nM - fm) < WGM ? (nM - fm) : WGM;
        u.pm = fm + ((wgid % nig) % gsz); u.pn = (wgid % nig) / gsz; u.kt0 = 0; u.nkt = ntk; u.role = 0; u.slot = 0;
        if (ksplit == 2) { u.slot = u.pn & 1; u.pn >>= 1; u.nkt = ntk >> 1; u.kt0 = u.slot * u.nkt; }
        return true;
    }
    __device__ __forceinline__ int expert(int pm) const { return (pm >= t1) + (pm >= t2) + (pm >= t3) + (pm >= t4) + (pm >= t5) + (pm >= t6) + (pm >= t7); }
    __device__ __forceinline__ const char* b_base(const Gemm& g, const Unit& u) const { return (const char*)g.Bt + (size_t)expert(u.pm) * estride; }
    __device__ __forceinline__ void a_ready(const Unit&) const {}
    __device__ __forceinline__ void done(const Unit&) const {}
};
struct GatherOrder : StaticOrder {
    static constexpr bool GATHER = true;
    const PG8_LAS unsigned* tok;
    __device__ __forceinline__ void load_offs(int ui, const int (&R)[2], const unsigned (&C)[2], unsigned (&o)[2][2]) const {
#pragma unroll
        for (int h = 0; h < 2; ++h)
#pragma unroll
            for (int i = 0; i < 2; ++i) o[h][i] = tok[ui * 256 + h * 128 + R[i]] + C[i];
    }
};
struct StreamKOrder : StaticOrder {
    int v, R, F;
    __device__ void init_sk(int nM_, int nN_, int G_, int bid, int ntk_) {
        init(nM_, nN_, G_, bid, ntk_); v = (G_ % 8 == 0) ? (bid % 8) * (G_ / 8) + bid / 8 : bid; F = nwg * ntk_; R = (((F + G_ - 1) / G_) + 1) & ~1; }
    __device__ __forceinline__ bool next(int i, Unit& u) const {
        const int start = v * R, end = (start + R < F) ? start + R : F;
        if (start >= F) return false;
        const int u0 = start / ntk, k0 = start - u0 * ntk, ui = u0 + i, fu = ui * ntk, kbeg = i == 0 ? k0 : 0;
        if (fu + kbeg >= end) return false;
        const int kend = (end - fu < ntk) ? end - fu : ntk;
        u.pm = ui / nN; u.pn = ui - u.pm * nN; u.kt0 = kbeg; u.nkt = kend - kbeg;
        u.role = kbeg > 0 ? 1 : (kend < ntk ? 2 : 0); u.slot = kbeg > 0 ? v - 1 : v; return true;
    }
};
__device__ __forceinline__ unsigned cvt_pk_bf16(float lo, float hi) { return ::pk2(lo, hi); }
constexpr float F8_ACT_SCALE = 16.f, F8_W_SCALE = 256.f, F8_Y_SCALE = 32.f;
constexpr int F8_ACT_E8M0 = 0x7b7b7b7b, F8_W_E8M0 = 0x77777777;
constexpr float F8_WG_SCALE = 256.f * 1.4426950408889634f, F8_WU_SCALE = 256.f / 1.4426950408889634f;
constexpr int F8_WU_E8M0 = 0x7b7b7b7b;
__device__ __forceinline__ unsigned cvt_pk4_fp8(float a, float b, float c, float d) {
    int w = __builtin_bit_cast(int, a);
    w = __builtin_amdgcn_cvt_pk_fp8_f32(a, b, w, false);
    w = __builtin_amdgcn_cvt_pk_fp8_f32(c, d, w, true);
    return (unsigned)w;
}
__device__ __forceinline__ i32x8 cat8(bf16x8 lo, bf16x8 hi) { const i32x4 x = __builtin_bit_cast(i32x4, lo), y = __builtin_bit_cast(i32x4, hi); return __builtin_shufflevector(x, y, 0, 1, 2, 3, 4, 5, 6, 7); }

#define PG8_ZERO_INIT_ACC __device__ __forceinline__ void init_acc(f32x4 (&acc)[2][2][4][2], const Unit&, int) const { \
    _Pragma("unroll") for (int a = 0; a < 2; ++a) _Pragma("unroll") for (int b = 0; b < 2; ++b) _Pragma("unroll") for (int m = 0; m < 4; ++m) _Pragma("unroll") for (int n = 0; n < 2; ++n) acc[a][b][m][n] = (f32x4){0.f, 0.f, 0.f, 0.f}; }
struct EpiProj {
    PG8_ZERO_INIT_ACC
    static constexpr bool PERM = true, AFTER_DRAIN = false, ZERO_BY_MFMA = true; static constexpr int W1_E8M0 = F8_W_E8M0;
    bf16_t* P; float* S;
    __device__ __forceinline__ void operator()(const f32x4 (&acc)[2][2][4][2], const Unit& u, int wr, int wc, int fr, int fq) const {
        const int row0 = u.pm * BM + wr * 64 + fr;
        if (u.pn < 11) {
            const int col0 = u.pn * BM + wc * 32 + 8 * fq;
#pragma unroll
            for (int ai = 0; ai < 2; ++ai)
#pragma unroll
                for (int m = 0; m < 4; ++m) { bf16_t* rowp = P + (size_t)(row0 + ai * HALF + m * 16) * PROJ_LD + col0;
#pragma unroll
                    for (int bj = 0; bj < 2; ++bj) { const f32x4 v0 = acc[ai][bj][m][0], v1 = acc[ai][bj][m][1];
                        u32x4 w; w.x = cvt_pk_bf16(v0[0], v0[1]); w.y = cvt_pk_bf16(v0[2], v0[3]); w.z = cvt_pk_bf16(v1[0], v1[1]); w.w = cvt_pk_bf16(v1[2], v1[3]);
                        *(u32x4*)(rowp + bj * HALF) = w; } }
        } else if (wc == 0) {
#pragma unroll
            for (int ai = 0; ai < 2; ++ai)
#pragma unroll
                for (int m = 0; m < 4; ++m) { float* rowp = S + (size_t)(row0 + ai * HALF + m * 16) * 32 + 8 * fq;
                    *(f32x4*)(rowp) = acc[ai][0][m][0]; *(f32x4*)(rowp + 4) = acc[ai][0][m][1]; }
        }
    }
};
struct EpiResid {
    PG8_ZERO_INIT_ACC
    static constexpr bool PERM = true, AFTER_DRAIN = false, ZERO_BY_MFMA = true; static constexpr int W1_E8M0 = F8_W_E8M0;
    const float* basef; bf16_t* X; const float* gate; float gs;
    __device__ __forceinline__ void operator()(const f32x4 (&acc)[2][2][4][2], const Unit& u, int wr, int wc, int fr, int fq) const {
        const int row0 = u.pm * BM + wr * 64 + fr, col0 = u.pn * BM + wc * 32 + 8 * fq;
        const float* gp = gate + (size_t)(u.pm >> 5) * 6144 + col0;
        f32x4 gv[2][2];
#pragma unroll
        for (int bj = 0; bj < 2; ++bj)
#pragma unroll
            for (int n = 0; n < 2; ++n) gv[bj][n] = *(const f32x4*)(gp + bj * HALF + 4 * n) * gs;
        if (basef) {
#pragma unroll
            for (int q2 = 0; q2 < 4; ++q2) { f32x4 b[8];
#pragma unroll
                for (int mm = 0; mm < 2; ++mm) { const int ai = q2 >> 1, m = (q2 & 1) * 2 + mm; const size_t off = (size_t)(row0 + ai * HALF + m * 16) * D + col0;
#pragma unroll
                    for (int bj = 0; bj < 2; ++bj) { b[mm * 4 + bj * 2] = *(const f32x4*)(basef + off + bj * HALF); b[mm * 4 + bj * 2 + 1] = *(const f32x4*)(basef + off + bj * HALF + 4); } }
                PIN8(b);
#pragma unroll
                for (int mm = 0; mm < 2; ++mm) { const int ai = q2 >> 1, m = (q2 & 1) * 2 + mm; const size_t off = (size_t)(row0 + ai * HALF + m * 16) * D + col0;
#pragma unroll
                    for (int bj = 0; bj < 2; ++bj) { const f32x4 v0 = b[mm * 4 + bj * 2] + gv[bj][0] * acc[ai][bj][m][0], v1 = b[mm * 4 + bj * 2 + 1] + gv[bj][1] * acc[ai][bj][m][1];
                        u32x4 w; w.x = cvt_pk_bf16(v0[0], v0[1]); w.y = cvt_pk_bf16(v0[2], v0[3]); w.z = cvt_pk_bf16(v1[0], v1[1]); w.w = cvt_pk_bf16(v1[2], v1[3]);
                        *(u32x4*)(X + off + bj * HALF) = w; } } }
        } else {
#pragma unroll
            for (int ai = 0; ai < 2; ++ai) { u32x4 xb[8];
#pragma unroll
                for (int m = 0; m < 4; ++m) { const size_t off = (size_t)(row0 + ai * HALF + m * 16) * D + col0; xb[2 * m] = *(const u32x4*)(X + off); xb[2 * m + 1] = *(const u32x4*)(X + off + HALF); }
                PIN8(xb);
#pragma unroll
                for (int m = 0; m < 4; ++m) { const size_t off = (size_t)(row0 + ai * HALF + m * 16) * D + col0;
#pragma unroll
                    for (int bj = 0; bj < 2; ++bj) { const u32x4 x = xb[2 * m + bj];
                        const f32x4 b0 = (f32x4){bflo(x.x), bfhi(x.x), bflo(x.y), bfhi(x.y)}, b1 = (f32x4){bflo(x.z), bfhi(x.z), bflo(x.w), bfhi(x.w)};
                        const f32x4 v0 = b0 + gv[bj][0] * acc[ai][bj][m][0], v1 = b1 + gv[bj][1] * acc[ai][bj][m][1];
                        u32x4 w; w.x = cvt_pk_bf16(v0[0], v0[1]); w.y = cvt_pk_bf16(v0[2], v0[3]); w.z = cvt_pk_bf16(v1[0], v1[1]); w.w = cvt_pk_bf16(v1[2], v1[3]);
                        *(u32x4*)(X + off + bj * HALF) = w; } } }
        }
    }
};
template <bool F8> struct EpiSwiglu {
    PG8_ZERO_INIT_ACC
    static constexpr bool PERM = true, AFTER_DRAIN = false, ZERO_BY_MFMA = true; static constexpr int W1_E8M0 = F8_WU_E8M0;
    bf16_t* Hd;
    __device__ __forceinline__ void operator()(const f32x4 (&acc)[2][2][4][2], const Unit& u, int wr, int wc, int fr, int fq) const {
        const int row0 = u.pm * BM + wr * 64 + fr, col0 = u.pn * HALF + wc * 32 + 8 * fq;
#pragma unroll
        for (int ai = 0; ai < 2; ++ai)
#pragma unroll
            for (int m = 0; m < 4; ++m) {
                float h[8];
#pragma unroll
                for (int n = 0; n < 2; ++n) { const f32x4 gt = acc[ai][0][m][n], up = acc[ai][1][m][n]; f32x4 hv;
                    if constexpr (F8) { const f32x4 den = (f32x4){__builtin_amdgcn_exp2f(-gt[0]), __builtin_amdgcn_exp2f(-gt[1]), __builtin_amdgcn_exp2f(-gt[2]), __builtin_amdgcn_exp2f(-gt[3])} + 1.0f;
                        hv = gt * (f32x4){__builtin_amdgcn_rcpf(den[0]), __builtin_amdgcn_rcpf(den[1]), __builtin_amdgcn_rcpf(den[2]), __builtin_amdgcn_rcpf(den[3])} * up; }
                    else { const f32x4 den = (f32x4){__expf(-gt[0]), __expf(-gt[1]), __expf(-gt[2]), __expf(-gt[3])} + 1.0f;
                        hv = gt * (f32x4){__builtin_amdgcn_rcpf(den[0]), __builtin_amdgcn_rcpf(den[1]), __builtin_amdgcn_rcpf(den[2]), __builtin_amdgcn_rcpf(den[3])} * up; }
                    h[4 * n] = hv[0]; h[4 * n + 1] = hv[1]; h[4 * n + 2] = hv[2]; h[4 * n + 3] = hv[3]; }
                if constexpr (F8) { unsigned char* rowp = (unsigned char*)Hd + (size_t)(row0 + ai * HALF + m * 16) * DFF + col0;
                    u32x2 w; w.x = cvt_pk4_fp8(h[0], h[1], h[2], h[3]); w.y = cvt_pk4_fp8(h[4], h[5], h[6], h[7]);
                    *(u32x2*)(rowp) = w; }
                else { bf16_t* rowp = Hd + (size_t)(row0 + ai * HALF + m * 16) * DFF + col0;
                    u32x4 w; w.x = cvt_pk_bf16(h[0], h[1]); w.y = cvt_pk_bf16(h[2], h[3]); w.z = cvt_pk_bf16(h[4], h[5]); w.w = cvt_pk_bf16(h[6], h[7]);
                    *(u32x4*)(rowp) = w; } }
    }
};
struct EpiMoeDown {
    static constexpr bool PERM = true, AFTER_DRAIN = false, ZERO_BY_MFMA = true; static constexpr int W1_E8M0 = F8_W_E8M0;
    bf16_t* Y2; const int* rowinfo;
    bf16_t* Y2b;
    unsigned char* part; unsigned* cnt;
    __device__ __forceinline__ void init_acc(f32x4 (&acc)[2][2][4][2], const Unit& u, int tid) const {
        if (u.role == 2) {
            if (tid < 64) { unsigned sp = 0;
                while ((unsigned)__builtin_amdgcn_readfirstlane((int)__hip_atomic_load(cnt + 64 * u.slot, __ATOMIC_RELAXED, __HIP_MEMORY_SCOPE_AGENT)) < 8u) { __builtin_amdgcn_s_sleep(2); if (++sp > (1u << 20)) break; }
                __builtin_amdgcn_fence(__ATOMIC_ACQUIRE, "agent");
                asm volatile("s_waitcnt vmcnt(0)" ::: "memory"); }
            asm volatile("" ::: "memory"); __builtin_amdgcn_s_barrier(); asm volatile("" ::: "memory");
            int t2 = tid; asm volatile("" : "+v"(t2));
            unsigned char* sb = part + (size_t)u.slot * 262144; sb = (unsigned char*)(((unsigned long long)(unsigned)__builtin_amdgcn_readfirstlane((int)((unsigned long long)sb >> 32)) << 32) | (unsigned)__builtin_amdgcn_readfirstlane((int)(unsigned long long)sb));
            const __amdgpu_buffer_rsrc_t rs = __builtin_amdgcn_make_buffer_rsrc(sb, 0, 262144, 0x00020000);
#pragma unroll
            for (int ai = 0; ai < 2; ++ai)
#pragma unroll
                for (int bj = 0; bj < 2; ++bj)
#pragma unroll
                    for (int m = 0; m < 4; ++m)
#pragma unroll
                        for (int n = 0; n < 2; ++n) acc[ai][bj][m][n] = __builtin_bit_cast(f32x4, __builtin_amdgcn_raw_buffer_load_b128(rs, (unsigned)(((((ai * 2 + bj) * 4 + m) * 2 + n) * 512 + t2) * 16), 0, 16));
        } else {
#pragma unroll
            for (int ai = 0; ai < 2; ++ai)
#pragma unroll
                for (int bj = 0; bj < 2; ++bj)
#pragma unroll
                    for (int m = 0; m < 4; ++m)
#pragma unroll
                        for (int n = 0; n < 2; ++n) acc[ai][bj][m][n] = (f32x4){0.f, 0.f, 0.f, 0.f};
        }
    }
    __device__ __forceinline__ void operator()(f32x4 (&acc)[2][2][4][2], const Unit& u, int wr, int wc, int fr, int fq) const {
        if (u.role == 1) {
            int lane = fq * 16 + fr; asm volatile("" : "+v"(lane)); const int tid = (wr * 4 + wc) * 64 + lane;
            unsigned char* sb = part + (size_t)u.slot * 262144; sb = (unsigned char*)(((unsigned long long)(unsigned)__builtin_amdgcn_readfirstlane((int)((unsigned long long)sb >> 32)) << 32) | (unsigned)__builtin_amdgcn_readfirstlane((int)(unsigned long long)sb));
            const __amdgpu_buffer_rsrc_t rs = __builtin_amdgcn_make_buffer_rsrc(sb, 0, 262144, 0x00020000);
#pragma unroll
            for (int ai = 0; ai < 2; ++ai)
#pragma unroll
                for (int bj = 0; bj < 2; ++bj)
#pragma unroll
                    for (int m = 0; m < 4; ++m)
#pragma unroll
                        for (int n = 0; n < 2; ++n) __builtin_amdgcn_raw_buffer_store_b128(__builtin_bit_cast(u32x4, acc[ai][bj][m][n]), rs, (unsigned)(((((ai * 2 + bj) * 4 + m) * 2 + n) * 512 + tid) * 16), 0, 16);
            asm volatile("s_waitcnt vmcnt(0)" ::: "memory");
            if (lane == 0) __hip_atomic_fetch_add(cnt + 64 * u.slot, 1u, __ATOMIC_RELAXED, __HIP_MEMORY_SCOPE_AGENT);
            return;
        }
        const int row0 = u.pm * BM + wr * 64 + fr, col0 = u.pn * BM + wc * 32 + 8 * fq;
        u32x2 ri[8];
#pragma unroll
        for (int q = 0; q < 8; ++q) ri[q] = *(const u32x2*)(rowinfo + 2 * (row0 + (q >> 2) * HALF + (q & 3) * 16));
        PIN8(ri);
#pragma unroll
        for (int ai = 0; ai < 2; ++ai)
#pragma unroll
            for (int m = 0; m < 4; ++m) { const unsigned tiu = ri[ai * 4 + m].x, pu = ri[ai * 4 + m].y; const int ti = (int)tiu; const float p = __builtin_bit_cast(float, pu);
                if (ti >= 0) { const int tok = ti & 0x3fffffff, k = ti >> 30; unsigned char* rowp = (unsigned char*)((u.role == 0 && u.slot) ? Y2b : Y2) + ((size_t)k * T + tok) * D + col0;
                    const float ps = p * F8_Y_SCALE;
#pragma unroll
                    for (int bj = 0; bj < 2; ++bj) { const f32x4 v0 = acc[ai][bj][m][0] * ps, v1 = acc[ai][bj][m][1] * ps;
                        u32x2 w; w.x = cvt_pk4_fp8(v0[0], v0[1], v0[2], v0[3]); w.y = cvt_pk4_fp8(v1[0], v1[1], v1[2], v1[3]);
                        *(u32x2*)(rowp + bj * HALF) = w; } } }
    }
};

template <class Epi, class Sched, bool ALIGN_EPI = false, bool SP2 = false, bool FP8 = false>
__device__ __forceinline__ void gemm_phase(PG8_LAS unsigned char* lds, const Gemm g, const Sched& S, const Epi& E, const int tid) {
    const int wid = __builtin_amdgcn_readfirstlane(tid >> 6), lane = tid & 63, wr = wid >> 2, wc = wid & 3, fr = lane & 15, fq = lane >> 4;
    const int K = g.K;
    unsigned voffA[2], voffB[2];
#pragma unroll
    for (int i = 0; i < 2; ++i) { int R, C; stage_rc(tid * 16 + i * 8192, R, C); const int Rb = Epi::PERM ? ((R & ~31) + perm32(R & 31)) : R;
        voffA[i] = (unsigned)(R * K + C) * 2u; voffB[i] = (unsigned)(Rb * K + C) * 2u; }
    unsigned cAo[2][2] = {{0u, 0u}, {0u, 0u}}, nAo[2][2] = {{0u, 0u}, {0u, 0u}};
    int gR[2] = {0, 0}; unsigned gC[2] = {0u, 0u};
    if constexpr (Sched::GATHER) {
#pragma unroll
        for (int i = 0; i < 2; ++i) { int R, C; stage_rc(tid * 16 + i * 8192, R, C); gR[i] = R; gC[i] = (unsigned)C * 2u; } }
    const size_t kstep = (size_t)(BK * 2);
    const size_t hstep = (size_t)HALF * K * 2;
    const size_t tstep = 2 * hstep;
    const unsigned ldsw = (unsigned)wid * 1024u;
    const int aoff = lds_byte(wr * 64 + fr, fq * 8), boff = lds_byte(wc * 32 + fr, fq * 8);
#define PG8_SA(b, h) (((b) * 2 + (h)) * HTB)
#define PG8_SB(b, h) ((4 + (b) * 2 + (h)) * HTB)
#define PG8_STAGE(bufoff, gbase, voff) do { _Pragma("unroll") for (int _i = 0; _i < 2; ++_i) \
        __builtin_amdgcn_global_load_lds((const unsigned*)((const char*)(gbase) + (voff)[_i]), (PG8_LAS unsigned*)(lds + (bufoff) + ldsw + _i * 8192), 16, 0, 0); } while (0)
#define PG8_STAGE_A(b, h, gbase, nx) do { if constexpr (Sched::GATHER) { const unsigned _o[2] = {(nx) ? nAo[h][0] : cAo[h][0], (nx) ? nAo[h][1] : cAo[h][1]}; PG8_STAGE(PG8_SA(b, h), gbase, _o); } \
        else { PG8_STAGE(PG8_SA(b, h), (gbase) + (h) * hstep, voffA); } } while (0)
#define PG8_LDA(dst, b, h) do { _Pragma("unroll") for (int m = 0; m < 4; ++m) _Pragma("unroll") for (int k = 0; k < 2; ++k) dst[m][k] = *(const PG8_LAS bf16x8*)(lds + PG8_SA(b, h) + aoff + m * 2048 + k * 1024); } while (0)
#define PG8_LDB(dst, b, h) do { _Pragma("unroll") for (int n = 0; n < 2; ++n) _Pragma("unroll") for (int k = 0; k < 2; ++k) dst[n][k] = *(const PG8_LAS bf16x8*)(lds + PG8_SB(b, h) + boff + n * 2048 + k * 1024); } while (0)
#define PG8_MMA1(ai, bj, At, Bt, ZC) do { _Pragma("unroll") for (int m = 0; m < 4; ++m) _Pragma("unroll") for (int n = 0; n < 2; ++n) { \
        if constexpr (FP8) { if constexpr (ZC) asm volatile("s_nop 1\n\tv_mfma_scale_f32_16x16x128_f8f6f4 %0, %1, %2, 0, %3, %4 op_sel_hi:[0,0,0]" : "=&v"(acc[ai][bj][m][n]) : "v"(cat8(Bt[n][0], Bt[n][1])), "v"(cat8(At[m][0], At[m][1])), "v"((bj) == 1 ? Epi::W1_E8M0 : F8_W_E8M0), "v"(F8_ACT_E8M0)); \
            else asm volatile("s_nop 1\n\tv_mfma_scale_f32_16x16x128_f8f6f4 %0, %1, %2, %0, %3, %4 op_sel_hi:[0,0,0]" : "+v"(acc[ai][bj][m][n]) : "v"(cat8(Bt[n][0], Bt[n][1])), "v"(cat8(At[m][0], At[m][1])), "v"((bj) == 1 ? Epi::W1_E8M0 : F8_W_E8M0), "v"(F8_ACT_E8M0)); } \
        else { acc[ai][bj][m][n] = __builtin_amdgcn_mfma_f32_16x16x32_bf16(Bt[n][0], At[m][0], ZC ? (f32x4){0.f, 0.f, 0.f, 0.f} : acc[ai][bj][m][n], 0, 0, 0); \
               acc[ai][bj][m][n] = __builtin_amdgcn_mfma_f32_16x16x32_bf16(Bt[n][1], At[m][1], acc[ai][bj][m][n], 0, 0, 0); } } } while (0)
#define PG8_MMAZ(ai, bj, At, Bt, Z) do { __builtin_amdgcn_s_setprio(1); if constexpr (FP8) { if (Z) PG8_MMA1(ai, bj, At, Bt, true); else PG8_MMA1(ai, bj, At, Bt, false); } else PG8_MMA1(ai, bj, At, Bt, false); __builtin_amdgcn_s_setprio(0); } while (0)
#define PG8_MMA(ai, bj, At, Bt) do { __builtin_amdgcn_s_setprio(1); PG8_MMA1(ai, bj, At, Bt, false); __builtin_amdgcn_s_setprio(0); } while (0)
#define PG8_WAIT_V(n) asm volatile("s_waitcnt vmcnt(" #n ")" ::: "memory")
#define PG8_WAIT_L(n) asm volatile("s_waitcnt lgkmcnt(" #n ")" ::: "memory")
#define PG8_BAR __builtin_amdgcn_s_barrier()
#define PG8_SCHED __builtin_amdgcn_sched_barrier(0)
    Unit cur, nxt; int ui = 0;
    if (!S.next(0, cur)) return;
    f32x4 acc[2][2][4][2];
    E.init_acc(acc, cur, tid);
    bf16x8 At[4][2], B0[2][2], B1[2][2];
    const char* cA = (const char*)g.A + (Sched::GATHER ? (size_t)0 : (size_t)cur.pm * tstep) + (size_t)cur.kt0 * kstep;
    if constexpr (Sched::GATHER) S.load_offs(0, gR, gC, cAo); const char* cB = S.b_base(g, cur) + (size_t)cur.pn * tstep + (size_t)cur.kt0 * kstep;
    S.a_ready(cur);
    if constexpr (SP2) {
        PG8_STAGE(PG8_SB(0, 0), cB, voffB); PG8_STAGE(PG8_SB(0, 1), cB + hstep, voffB); PG8_STAGE_A(0, 0, cA, false); PG8_STAGE_A(0, 1, cA, false);
        if (wr == 1) PG8_BAR;
        PG8_WAIT_V(2); PG8_BAR;
        PG8_STAGE(PG8_SB(1, 0), cB + kstep, voffB); PG8_STAGE_A(1, 0, cA + kstep, false); PG8_STAGE(PG8_SB(1, 1), cB + hstep + kstep, voffB);
        PG8_WAIT_V(6); PG8_BAR;
    } else {
        PG8_STAGE(PG8_SB(0, 0), cB, voffB); PG8_STAGE_A(0, 0, cA, false); PG8_STAGE(PG8_SB(0, 1), cB + hstep, voffB); PG8_STAGE_A(0, 1, cA, false);
        if (wr == 1) PG8_BAR;
        PG8_WAIT_V(4); PG8_BAR;
        PG8_STAGE(PG8_SB(1, 0), cB + kstep, voffB); PG8_STAGE_A(1, 0, cA + kstep, false); PG8_STAGE(PG8_SB(1, 1), cB + hstep + kstep, voffB);
        PG8_WAIT_V(6); PG8_BAR;
    }
    for (;;) {
        const bool has_next = S.next(ui + 1, nxt);
        const char* nA = has_next ? (const char*)g.A + (Sched::GATHER ? (size_t)0 : (size_t)nxt.pm * tstep) + (size_t)nxt.kt0 * kstep : cA;
        if constexpr (Sched::GATHER) { if (has_next) S.load_offs(ui + 1, gR, gC, nAo); } const char* nB = has_next ? S.b_base(g, nxt) + (size_t)nxt.pn * tstep + (size_t)nxt.kt0 * kstep : cB;
        const int nt = cur.nkt;
        for (int t = 0; t < nt; t += 2) {
            const bool last = (t == nt - 2);
            const bool nx = last && has_next; (void)nx;
            const char* a1 = cA + (size_t)(t + 1) * kstep;
            const char* a2 = last ? nA : cA + (size_t)(t + 2) * kstep; const char* b2 = last ? nB : cB + (size_t)(t + 2) * kstep;
            const char* a3 = a2 + kstep; const char* b3 = b2 + kstep;
            if (last && has_next) S.a_ready(nxt);
            if constexpr (SP2) {
            PG8_LDB(B0, 0, 0); PG8_LDB(B1, 0, 1); PG8_SCHED; PG8_LDA(At, 0, 0); PG8_STAGE_A(1, 1, a1, false);
            PG8_WAIT_V(8); PG8_WAIT_L(0); PG8_BAR; PG8_MMAZ(0, 0, At, B0, t == 0); PG8_MMAZ(0, 1, At, B1, t == 0); PG8_BAR; PG8_SCHED;
            PG8_LDA(At, 0, 1); PG8_STAGE(PG8_SB(0, 0), b2, voffB); PG8_STAGE(PG8_SB(0, 1), b2 + hstep, voffB); PG8_STAGE_A(0, 0, a2, nx);
            PG8_WAIT_V(8); PG8_WAIT_L(0); PG8_BAR; PG8_MMAZ(1, 0, At, B0, t == 0); PG8_MMAZ(1, 1, At, B1, t == 0); PG8_BAR; PG8_SCHED;
            PG8_LDB(B0, 1, 0); PG8_LDB(B1, 1, 1); PG8_SCHED; PG8_LDA(At, 1, 0); PG8_STAGE_A(0, 1, a2, nx);
            PG8_WAIT_V(8); PG8_WAIT_L(0); PG8_BAR; PG8_MMA(0, 0, At, B0); PG8_MMA(0, 1, At, B1); PG8_BAR; PG8_SCHED;
            PG8_LDA(At, 1, 1); PG8_STAGE(PG8_SB(1, 0), b3, voffB); PG8_STAGE(PG8_SB(1, 1), b3 + hstep, voffB); PG8_STAGE_A(1, 0, a3, nx);
            PG8_WAIT_V(8); PG8_WAIT_L(0); PG8_BAR; PG8_MMA(1, 0, At, B0); PG8_MMA(1, 1, At, B1); PG8_BAR; PG8_SCHED;
            } else {
            PG8_LDB(B0, 0, 0); PG8_SCHED; PG8_LDA(At, 0, 0); PG8_STAGE_A(1, 1, a1, false);
            PG8_WAIT_L(8); PG8_BAR; PG8_WAIT_L(0); PG8_MMAZ(0, 0, At, B0, t == 0); PG8_BAR; PG8_SCHED;
            PG8_LDB(B1, 0, 1); PG8_STAGE(PG8_SB(0, 0), b2, voffB);
            PG8_BAR; PG8_WAIT_L(0); PG8_MMAZ(0, 1, At, B1, t == 0); PG8_BAR;
            PG8_LDA(At, 0, 1); PG8_STAGE_A(0, 0, a2, nx);
            PG8_BAR; PG8_WAIT_L(0); PG8_MMAZ(1, 0, At, B0, t == 0); PG8_BAR; PG8_SCHED;
            PG8_STAGE(PG8_SB(0, 1), b2 + hstep, voffB);
            PG8_WAIT_V(6); PG8_BAR; PG8_MMAZ(1, 1, At, B1, t == 0); PG8_BAR;
            PG8_LDB(B0, 1, 0); PG8_SCHED; PG8_LDA(At, 1, 0); PG8_STAGE_A(0, 1, a2, nx);
            PG8_WAIT_L(8); PG8_BAR; PG8_WAIT_L(0); PG8_MMA(0, 0, At, B0); PG8_BAR; PG8_SCHED;
            PG8_LDB(B1, 1, 1); PG8_STAGE(PG8_SB(1, 0), b3, voffB);
            PG8_BAR; PG8_WAIT_L(0); PG8_MMA(0, 1, At, B1); PG8_BAR;
            PG8_LDA(At, 1, 1); PG8_STAGE_A(1, 0, a3, nx);
            PG8_BAR; PG8_WAIT_L(0); PG8_MMA(1, 0, At, B0); PG8_BAR; PG8_SCHED;
            PG8_STAGE(PG8_SB(1, 1), b3 + hstep, voffB);
            PG8_WAIT_V(6); PG8_BAR; PG8_MMA(1, 1, At, B1); PG8_BAR;
            }
        }
        if constexpr (ALIGN_EPI) { if (wr == 0) PG8_BAR; }
        if constexpr (FP8) asm volatile("s_nop 15\n\ts_nop 15" ::: "memory");
        if constexpr (!Epi::AFTER_DRAIN) { E(acc, cur, wr, wc, fr, fq); S.done(cur); }
        if (!has_next) break;
        if constexpr (!(Epi::ZERO_BY_MFMA && FP8)) E.init_acc(acc, nxt, tid);
        cur = nxt; cA = nA; cB = nB; ++ui;
        if constexpr (Sched::GATHER) { cAo[0][0] = nAo[0][0]; cAo[0][1] = nAo[0][1]; cAo[1][0] = nAo[1][0]; cAo[1][1] = nAo[1][1]; }
        if constexpr (ALIGN_EPI) { if (wr == 1) PG8_BAR; }
    }
    PG8_WAIT_V(0);
    if constexpr (!ALIGN_EPI) { if (wr == 0) PG8_BAR; }
    PG8_BAR;
    if constexpr (Epi::AFTER_DRAIN) { E.fused(acc, cur, wr, wc, fr, fq, lds, wid, lane); S.done(cur); }
#undef PG8_SA
#undef PG8_STAGE_A
#undef PG8_SB
#undef PG8_STAGE
#undef PG8_LDA
#undef PG8_LDB
#undef PG8_MMA
#undef PG8_MMA1
#undef PG8_MMAZ
#undef PG8_WAIT_V
#undef PG8_WAIT_L
#undef PG8_BAR
#undef PG8_SCHED
}
}

enum { I_X = 0, I_C, I_ADAW, I_ADAB, I_N1W, I_WIN, I_GAW, I_GAB, I_GNW, I_CONVW, I_CONVB, I_DTB, I_ALOG, I_DSKIP, I_SNW, I_WOUT, I_N2W, I_FG, I_FU, I_FD, I_RW, I_MG, I_MU, I_MD, I_FNW, N_IN };
struct Args { const float* in[N_IN]; float* out; unsigned char* ws; int ph_lo, ph_hi, dummy, pad; };
struct Ctx { unsigned char* ws; const LAS unsigned* tab; };
DI const float* inp(const LAS unsigned* tab, int i) {
    const unsigned lo = (unsigned)__builtin_amdgcn_readfirstlane((int)tab[2 * i]), hi = (unsigned)__builtin_amdgcn_readfirstlane((int)tab[2 * i + 1]);
    return (const float*)(const GAS float*)(((unsigned long long)hi << 32) | lo);
}
#define INP(i) inp(a.tab, (i))

DI void adaln_items(const Ctx& a, LAS unsigned char* lds, int tid, int lane, int wave) {
    LAS float* sl = (LAS float*)lds;
    LAS float* red = (LAS float*)(lds + 8192);
    const float* c = INP(I_C);
    for (int i = tid; i < 2 * D; i += NTHREADS) sl[i] = silu_f(c[i]);
    __syncthreads();
    float* MOD = (float*)(a.ws + WS_MOD);
    for (int item = blockIdx.x; item < 256; item += gridDim.x) {
        const int l = item >> 6, n0 = (item & 63) * 96;
        const int cq = lane % 24, rp = lane / 24;
        f32x4 a0 = {0.f, 0.f, 0.f, 0.f}, a1 = {0.f, 0.f, 0.f, 0.f};
        if (lane < 48) {
            const float* wp = INP(I_ADAW) + ((size_t)l * D + wave * 128 + rp) * 6144 + n0 + 4 * cq;
#pragma unroll 8
            for (int i = 0; i < 64; ++i) { const f32x4 w = *(const f32x4*)(wp + (size_t)(2 * i) * 6144); const int k = wave * 128 + 2 * i + rp; a0 += sl[k] * w; a1 += sl[D + k] * w; }
            LAS float* r0 = red + ((wave * 2 + rp) * 2 + 0) * 96 + 4 * cq; LAS float* r1 = red + ((wave * 2 + rp) * 2 + 1) * 96 + 4 * cq;
            r0[0] = a0[0]; r0[1] = a0[1]; r0[2] = a0[2]; r0[3] = a0[3]; r1[0] = a1[0]; r1[1] = a1[1]; r1[2] = a1[2]; r1[3] = a1[3];
        }
        __syncthreads();
        if (tid < 192) { const int b = tid / 96, col = tid % 96; float s = INP(I_ADAB)[l * 6144 + n0 + col];
#pragma unroll
            for (int q = 0; q < 16; ++q) s += red[(q * 2 + b) * 96 + col];
            MOD[(size_t)(l * 2 + b) * 6144 + n0 + col] = s; }
        __syncthreads();
    }
}
template <int MAP> DI int rowmap(int n) {
    if (MAP == 1) return (n < 1536) ? n : (n < 1552 ? n + 1280 : (n < 2832 ? n - 16 : n));
    if (MAP == 2) return (n >> 7) * 256 + (n & 127);
    if (MAP == 3) return (n >> 7) * 256 + 128 + (n & 127);
    return n;
}
template <int MAP, bool F8 = false> DI void convert_tile(const float* W, int K, int N, bf16* WT, int item, int lane) {
    const int nblk = (N + 63) / 64, kb = item / nblk, nb = item % nblk, k0 = 64 * kb, n0 = 64 * nb;
    const int q = lane >> 4, c = lane & 15, n = n0 + 4 * c;
    if (n >= N) return;
    const float* src = W + (size_t)(k0 + 16 * q) * N + n;
    f32x4 v[16];
#pragma unroll
    for (int i = 0; i < 16; ++i) v[i] = __builtin_nontemporal_load((const f32x4*)(src + (size_t)i * N));
    if constexpr (F8) {
#pragma unroll
        for (int i = 0; i < 16; ++i) v[i] = v[i] * (MAP == 2 ? pg8::F8_WG_SCALE : (MAP == 3 ? pg8::F8_WU_SCALE : pg8::F8_W_SCALE));
#pragma unroll
        for (int j = 0; j < 4; ++j) { unsigned char* dst = (unsigned char*)WT + (size_t)rowmap<MAP>(n + j) * K + k0 + 16 * q;
            u32x4 o; o.x = pg8::cvt_pk4_fp8(v[0][j], v[1][j], v[2][j], v[3][j]); o.y = pg8::cvt_pk4_fp8(v[4][j], v[5][j], v[6][j], v[7][j]);
            o.z = pg8::cvt_pk4_fp8(v[8][j], v[9][j], v[10][j], v[11][j]); o.w = pg8::cvt_pk4_fp8(v[12][j], v[13][j], v[14][j], v[15][j]);
            *(u32x4*)dst = o; }
        return; }
#pragma unroll
    for (int j = 0; j < 4; ++j) { bf16* dst = WT + (size_t)rowmap<MAP>(n + j) * K + k0 + 16 * q;
        u32x4 o0, o1;
        o0.x = pg8::cvt_pk_bf16(v[0][j], v[1][j]); o0.y = pg8::cvt_pk_bf16(v[2][j], v[3][j]); o0.z = pg8::cvt_pk_bf16(v[4][j], v[5][j]); o0.w = pg8::cvt_pk_bf16(v[6][j], v[7][j]);
        o1.x = pg8::cvt_pk_bf16(v[8][j], v[9][j]); o1.y = pg8::cvt_pk_bf16(v[10][j], v[11][j]); o1.z = pg8::cvt_pk_bf16(v[12][j], v[13][j]); o1.w = pg8::cvt_pk_bf16(v[14][j], v[15][j]);
        *(u32x4*)dst = o0; *(u32x4*)(dst + 8) = o1; }
}
DI void convert_weights(const Ctx& a, int lane, int wave) {
    const int gw = blockIdx.x * NWAVES + wave, NGW = gridDim.x * NWAVES;
    constexpr int I_IN = 16 * 45, I_O = 16 * 16, I_GU = 16 * 56, I_D = 56 * 16;
    constexpr int N0 = 4 * I_IN, N1 = N0 + 4 * I_O, N2 = N1 + 2 * I_GU, N3 = N2 + 2 * I_GU, N4 = N3 + 2 * I_D, N5 = N4 + 8 * I_GU, N6 = N5 + 8 * I_GU, N7 = N6 + 8 * I_D;
    unsigned char* ws = a.ws;
    for (int it = gw; it < N7; it += NGW) {
        if (it < N0) { const int m = it / I_IN, r = it % I_IN; convert_tile<1>(INP(I_WIN) + (size_t)m * D * NPROJ, D, NPROJ, (bf16*)(ws + WS_WIN) + (size_t)m * NPROJ_PAD * D, r, lane); }
        else if (it < N1) { const int q = it - N0, m = q / I_O, r = q % I_O; convert_tile<0>(INP(I_WOUT) + (size_t)m * D * D, D, D, (bf16*)(ws + WS_WOUT) + (size_t)m * D * D, r, lane); }
        else if (it < N2) { const int q = it - N1, m = q / I_GU, r = q % I_GU; convert_tile<2, true>(INP(I_FG) + (size_t)m * D * DFF, D, DFF, (bf16*)(ws + WS_WGU + (size_t)m * 2 * DFF * D), r, lane); }
        else if (it < N3) { const int q = it - N2, m = q / I_GU, r = q % I_GU; convert_tile<3, true>(INP(I_FU) + (size_t)m * D * DFF, D, DFF, (bf16*)(ws + WS_WGU + (size_t)m * 2 * DFF * D), r, lane); }
        else if (it < N4) { const int q = it - N3, m = q / I_D, r = q % I_D; convert_tile<0, true>(INP(I_FD) + (size_t)m * DFF * D, DFF, D, (bf16*)(ws + WS_WD + (size_t)m * D * DFF), r, lane); }
        else if (it < N5) { const int q = it - N4, m = q / I_GU, r = q % I_GU; convert_tile<2, true>(INP(I_MG) + (size_t)m * D * DFF, D, DFF, (bf16*)(ws + WS_MGU + (size_t)m * 2 * DFF * D), r, lane); }
        else if (it < N6) { const int q = it - N5, m = q / I_GU, r = q % I_GU; convert_tile<3, true>(INP(I_MU) + (size_t)m * D * DFF, D, DFF, (bf16*)(ws + WS_MGU + (size_t)m * 2 * DFF * D), r, lane); }
        else { const int q = it - N6, m = q / I_D, r = q % I_D; convert_tile<0, true>(INP(I_MD) + (size_t)m * DFF * D, DFF, D, (bf16*)(ws + WS_MD + (size_t)m * D * DFF), r, lane); }
    }
    for (int r = gw; r < 4 * 232; r += NGW) { const int m = r / 232, row = 2840 + r % 232; u32x4* p = (u32x4*)((bf16*)(ws + WS_WIN) + ((size_t)m * NPROJ_PAD + row) * D) + lane;
        const u32x4 z = {0u, 0u, 0u, 0u}; p[0] = z; p[64] = z; }
}
constexpr int MOE_LATE_ITEMS = 8 * (2 * 16 * 56 + 56 * 16), MOE_LATE_SPLIT = 3584;
DI void convert_moe_late(const Ctx& a, int gw, int ngw, int lane, int it0, int it1) {
    constexpr int I_GU = 16 * 56, I_D = 56 * 16, N5 = 8 * I_GU, N6 = N5 + 8 * I_GU, N7 = N6 + 8 * I_D;
    unsigned char* ws = a.ws;
    static_assert(N7 == MOE_LATE_ITEMS, "item count");
    for (int it = it0 + gw; it < it1; it += ngw) {
        if (it < N5) { const int m = 8 + it / I_GU, r = it % I_GU; convert_tile<2, true>(INP(I_MG) + (size_t)m * D * DFF, D, DFF, (bf16*)(ws + WS_MGU + (size_t)m * 2 * DFF * D), r, lane); }
        else if (it < N6) { const int q = it - N5, m = 8 + q / I_GU, r = q % I_GU; convert_tile<3, true>(INP(I_MU) + (size_t)m * D * DFF, D, DFF, (bf16*)(ws + WS_MGU + (size_t)m * 2 * DFF * D), r, lane); }
        else { const int q = it - N6, m = 8 + q / I_D, r = q % I_D; convert_tile<0, true>(INP(I_MD) + (size_t)m * DFF * D, DFF, D, (bf16*)(ws + WS_MD + (size_t)m * D * DFF), r, lane); }
    }
}

struct NormArgs { const float* xin; bf16* X; const float* nw; const float* sc; const float* sh; const float* g2; const bf16* Y2; bf16* H; float* out; int combine; const bf16* Y2b; };
DI void load16b(const bf16* p, int lane, f32x4 (&v)[4]) {
#pragma unroll
    for (int j = 0; j < 4; ++j) { const u32x2 w = *(const u32x2*)(p + 4 * lane + 256 * j); v[j] = (f32x4){bflo(w.x), bfhi(w.x), bflo(w.y), bfhi(w.y)}; }
}
DI void load16(const float* p, int lane, f32x4 (&v)[4]) {
#pragma unroll
    for (int j = 0; j < 4; ++j) v[j] = *(const f32x4*)(p + 4 * lane + 256 * j);
}
template <int MODE> DI void norm_phase(const Ctx& a, const NormArgs& na, LAS unsigned char* lds, int tid, int lane, int wave, const float* router_w, unsigned* cnt) {
    LAS float* WR = (LAS float*)lds;
    LAS int* SEL = (LAS int*)(lds + 32768);
    LAS int* LPOS = (LAS int*)(lds + 32768 + 1024);
    LAS int* BASE = (LAS int*)(lds + 32768 + 2048);
    if (MODE == 1) {
        for (int idx = tid; idx < D * NE; idx += NTHREADS) { const int c = idx >> 3, e = idx & 7, j = c >> 8, ln = (c & 255) >> 2, i = c & 3;
            WR[((((j * 4 + i) * 2 + (e >> 2)) * 64 + ln) << 2) + (e & 3)] = router_w[idx]; }
        __syncthreads(); }
    for (int rb = blockIdx.x * 64; rb < T; rb += gridDim.x * 64) {
        const int r0 = rb + wave * 8, b = r0 / SEQ;
        f32x4 mul[4], add[4], gv[4];
        if (MODE != 2) { f32x4 w[4], s[4]; load16(na.nw, lane, w); load16(na.sc + (size_t)b * 6144, lane, s); load16(na.sh + (size_t)b * 6144, lane, add);
#pragma unroll
            for (int j = 0; j < 4; ++j) mul[j] = w[j] * (1.0f + s[j]); }
        else { load16(na.nw, lane, mul); }
        if ((MODE == 2 && !(MK_DBG_SKIP & 4)) || na.combine) load16(na.g2 + (size_t)b * 6144, lane, gv);
        const bool comb = (MODE == 2 && !(MK_DBG_SKIP & 4)) || na.combine;
        if constexpr (MODE == 1) {
            u32x2 xb[4][4]; f32x4 hk[4][4];
            auto ld = [&](const int rq) {
#pragma unroll
                for (int r4 = 0; r4 < 4; ++r4)
#pragma unroll
                    for (int j = 0; j < 4; ++j) xb[r4][j] = *(const u32x2*)(na.X + (size_t)(r0 + rq + r4) * D + 4 * lane + 256 * j); };
            auto nrm = [&](const int rq) {
#pragma unroll
                for (int r4 = 0; r4 < 4; ++r4) { const size_t row = (size_t)(r0 + rq + r4); f32x4 v[4]; float ss = 0.f;
#pragma unroll
                    for (int j = 0; j < 4; ++j) { const u32x2 w = xb[r4][j]; v[j] = (f32x4){bflo(w.x), bfhi(w.x), bflo(w.y), bfhi(w.y)}; ss += (v[j][0] * v[j][0] + v[j][1] * v[j][1]) + (v[j][2] * v[j][2] + v[j][3] * v[j][3]); }
                    const float rstd = __builtin_amdgcn_rsqf(wave_sum(ss, lane) * (1.0f / D) + EPS);
#pragma unroll
                    for (int j = 0; j < 4; ++j) { const f32x4 h = v[j] * rstd * mul[j] + add[j]; hk[r4][j] = h; const f32x4 hs = h * pg8::F8_ACT_SCALE;
                        *(unsigned*)((unsigned char*)na.H + row * D + 4 * lane + 256 * j) = pg8::cvt_pk4_fp8(hs[0], hs[1], hs[2], hs[3]); } } };
            auto rt = [&](const int rq) {
                f32x2 lg[4][4];
#pragma unroll
                for (int r4 = 0; r4 < 4; ++r4)
#pragma unroll
                    for (int q = 0; q < 4; ++q) lg[r4][q] = (f32x2){0.f, 0.f};
#pragma unroll
                for (int j = 0; j < 4; ++j)
#pragma unroll
                    for (int i = 0; i < 4; ++i) { const LAS f32x4* wr = (const LAS f32x4*)WR + ((j * 4 + i) * 2) * 64 + lane; const f32x4 w0 = wr[0], w1 = wr[64];
                        const f32x2 wp[4] = {{w0[0], w0[1]}, {w0[2], w0[3]}, {w1[0], w1[1]}, {w1[2], w1[3]}};
#pragma unroll
                        for (int r4 = 0; r4 < 4; ++r4) { const float hv = hk[r4][j][i]; const f32x2 hv2 = {hv, hv};
#pragma unroll
                            for (int q = 0; q < 4; ++q) lg[r4][q] += hv2 * wp[q]; }
                        if (i == 1 || i == 3) __builtin_amdgcn_sched_barrier(0); }
#pragma unroll
                for (int r4 = 0; r4 < 4; ++r4) { const int rr = rq + r4;
                    const bool b5 = (lane & 32) != 0, b4 = (lane & 16) != 0, b3 = (lane & 8) != 0;
                    const f32x2 s0 = b5 ? lg[r4][0] : lg[r4][2], s1 = b5 ? lg[r4][1] : lg[r4][3], k0 = b5 ? lg[r4][2] : lg[r4][0], k1 = b5 ? lg[r4][3] : lg[r4][1];
                    f32x2 t0, t1; t0[0] = k0[0] + shfl_xor_l(s0[0], 32, lane); t0[1] = k0[1] + shfl_xor_l(s0[1], 32, lane); t1[0] = k1[0] + shfl_xor_l(s1[0], 32, lane); t1[1] = k1[1] + shfl_xor_l(s1[1], 32, lane);
                    const f32x2 s2 = b4 ? t0 : t1, k2 = b4 ? t1 : t0;
                    f32x2 u; u[0] = k2[0] + shfl_xor_l(s2[0], 16, lane); u[1] = k2[1] + shfl_xor_l(s2[1], 16, lane);
                    float t = (b3 ? u[1] : u[0]) + shfl_xor_l(b3 ? u[0] : u[1], 8, lane);
                    t += shfl_xor_l(t, 4, lane); t += shfl_xor_l(t, 2, lane); t += shfl_xor_l(t, 1, lane);
                    float l8[8];
#pragma unroll
                    for (int e = 0; e < 8; ++e) l8[e] = __builtin_bit_cast(float, __builtin_amdgcn_readlane(__builtin_bit_cast(int, t), 8 * e));
                    int e0 = 0; float v0 = l8[0];
#pragma unroll
                    for (int e = 1; e < 8; ++e) if (l8[e] > v0) { v0 = l8[e]; e0 = e; }
                    int e1 = -1; float v1 = -3.0e38f;
#pragma unroll
                    for (int e = 0; e < 8; ++e) if (e != e0 && l8[e] > v1) { v1 = l8[e]; e1 = e; }
                    const float p0 = __builtin_amdgcn_rcpf(1.0f + __expf(v1 - v0));
                    if (lane == 0) { LAS int* s = SEL + (wave * 8 + rr) * 4; s[0] = e0; s[1] = e1; s[2] = __builtin_bit_cast(int, p0); } } };
            ld(0); PIN8(&xb[0][0]); PIN8(&xb[2][0]);
            nrm(0);
            rt(0); __builtin_amdgcn_sched_barrier(0);
            ld(4); PIN8(&xb[0][0]); PIN8(&xb[2][0]);
            nrm(4);
            rt(4);
        } else
#pragma unroll 1
        for (int rq = 0; rq < 8; rq += 4) {
        f32x4 xf[4][4]; u32x2 xb[4][4]; unsigned ya[4][4], yb[4][4];
        if (na.xin) {
#pragma unroll
            for (int r4 = 0; r4 < 4; ++r4)
#pragma unroll
                for (int j = 0; j < 4; ++j) xf[r4][j] = *(const f32x4*)(na.xin + (size_t)(r0 + rq + r4) * D + 4 * lane + 256 * j);
            PIN8(&xf[0][0]); PIN8(&xf[2][0]);
        } else {
#pragma unroll
            for (int r4 = 0; r4 < 4; ++r4)
#pragma unroll
                for (int j = 0; j < 4; ++j) xb[r4][j] = *(const u32x2*)(na.X + (size_t)(r0 + rq + r4) * D + 4 * lane + 256 * j);
            PIN8(&xb[0][0]); PIN8(&xb[2][0]);
        }
        if (comb) {
#pragma unroll
            for (int r4 = 0; r4 < 4; ++r4)
#pragma unroll
                for (int j = 0; j < 4; ++j) { ya[r4][j] = *(const unsigned*)((const unsigned char*)na.Y2 + (size_t)(r0 + rq + r4) * D + 4 * lane + 256 * j); yb[r4][j] = *(const unsigned*)((const unsigned char*)na.Y2 + ((size_t)T + r0 + rq + r4) * D + 4 * lane + 256 * j); }
            PIN8(&ya[0][0]); PIN8(&ya[2][0]); PIN8(&yb[0][0]); PIN8(&yb[2][0]);
        }
#pragma unroll
        for (int r4 = 0; r4 < 4; ++r4) {
            const int rr = rq + r4, row = r0 + rr;
            f32x4 v[4];
#pragma unroll
            for (int j = 0; j < 4; ++j) { if (na.xin) v[j] = xf[r4][j]; else { const u32x2 w = xb[r4][j]; v[j] = (f32x4){bflo(w.x), bfhi(w.x), bflo(w.y), bfhi(w.y)}; } }
            if (comb) {
#pragma unroll
                for (int j = 0; j < 4; ++j) { const int y0 = (int)ya[r4][j], y1 = (int)yb[r4][j];
                    const f32x2 a0 = __builtin_amdgcn_cvt_pk_f32_fp8(y0, false), a1 = __builtin_amdgcn_cvt_pk_f32_fp8(y0, true), b0 = __builtin_amdgcn_cvt_pk_f32_fp8(y1, false), b1 = __builtin_amdgcn_cvt_pk_f32_fp8(y1, true);
                    f32x4 ys; ys[0] = (a0[0] + b0[0]) * (1.0f / pg8::F8_Y_SCALE); ys[1] = (a0[1] + b0[1]) * (1.0f / pg8::F8_Y_SCALE); ys[2] = (a1[0] + b1[0]) * (1.0f / pg8::F8_Y_SCALE); ys[3] = (a1[1] + b1[1]) * (1.0f / pg8::F8_Y_SCALE);
                    v[j] = v[j] + gv[j] * ys; if (MODE != 2) { u32x2 o; o.x = pk2(v[j][0], v[j][1]); o.y = pk2(v[j][2], v[j][3]); *(u32x2*)(na.X + (size_t)row * D + 4 * lane + 256 * j) = o; } }
            }
            float ss = 0.f;
#pragma unroll
            for (int j = 0; j < 4; ++j) ss += (v[j][0] * v[j][0] + v[j][1] * v[j][1]) + (v[j][2] * v[j][2] + v[j][3] * v[j][3]);
            const float rstd = __builtin_amdgcn_rsqf(wave_sum(ss, lane) * (1.0f / D) + EPS);
            if (MODE == 2) {
#pragma unroll
                for (int j = 0; j < 4; ++j) *(f32x4*)(na.out + (size_t)row * D + 4 * lane + 256 * j) = v[j] * rstd * mul[j];
            } else {
                f32x4 h[4];
#pragma unroll
                for (int j = 0; j < 4; ++j) { h[j] = v[j] * rstd * mul[j] + add[j];
                    if (MODE == 1 || MODE == 3) { const f32x4 hs = h[j] * pg8::F8_ACT_SCALE; *(unsigned*)((unsigned char*)na.H + (size_t)row * D + 4 * lane + 256 * j) = pg8::cvt_pk4_fp8(hs[0], hs[1], hs[2], hs[3]); }
                    else { u32x2 o; o.x = pk2(h[j][0], h[j][1]); o.y = pk2(h[j][2], h[j][3]); *(u32x2*)(na.H + (size_t)row * D + 4 * lane + 256 * j) = o; } }
                if (MODE == 1) {
                    float lg[8];
#pragma unroll
                    for (int e = 0; e < 8; ++e) lg[e] = 0.f;
#pragma unroll
                    for (int j = 0; j < 4; ++j)
#pragma unroll
                        for (int i = 0; i < 4; ++i) { const LAS f32x4* wr = (const LAS f32x4*)WR + ((j * 4 + i) * 2) * 64 + lane; const f32x4 w0 = wr[0], w1 = wr[64]; const float hv = h[j][i];
                            lg[0] += hv * w0[0]; lg[1] += hv * w0[1]; lg[2] += hv * w0[2]; lg[3] += hv * w0[3]; lg[4] += hv * w1[0]; lg[5] += hv * w1[1]; lg[6] += hv * w1[2]; lg[7] += hv * w1[3]; }
#pragma unroll
                    for (int e = 0; e < 8; ++e) lg[e] = wave_sum(lg[e], lane);
                    int e0 = 0; float v0 = lg[0];
#pragma unroll
                    for (int e = 1; e < 8; ++e) if (lg[e] > v0) { v0 = lg[e]; e0 = e; }
                    int e1 = -1; float v1 = -3.0e38f;
#pragma unroll
                    for (int e = 0; e < 8; ++e) if (e != e0 && lg[e] > v1) { v1 = lg[e]; e1 = e; }
                    const float p0 = 1.0f / (1.0f + expf(v1 - v0));
                    if (lane == 0) { LAS int* s = SEL + (wave * 8 + rr) * 4; s[0] = e0; s[1] = e1; s[2] = __builtin_bit_cast(int, p0); }
                }
            }
        }
        }
        if (MODE == 1) {
            __syncthreads();
            if (tid < 64) {
                const int e0 = SEL[tid * 4], e1 = SEL[tid * 4 + 1]; const unsigned long long lt = (1ull << tid) - 1ull; int r0 = 0, r1 = 0;
#pragma unroll
                for (int e = 0; e < 8; ++e) { const unsigned long long m0 = __ballot(e0 == e), m1 = __ballot(e1 == e); const int below = __popcll(m0 & lt) + __popcll(m1 & lt);
                    if (e0 == e) r0 = below; if (e1 == e) r1 = below;
                    if (tid == e) ((int*)(a.ws + WS_BLKCNT))[(rb >> 6) * 8 + e] = __popcll(m0) + __popcll(m1); }
                LPOS[tid * 2] = r0; LPOS[tid * 2 + 1] = r1; }
            __syncthreads();
            if (tid < 64) { const int e0 = SEL[tid * 4], e1 = SEL[tid * 4 + 1]; i32x4 o; o.x = e0 | (e1 << 8); o.y = LPOS[tid * 2]; o.z = LPOS[tid * 2 + 1]; o.w = SEL[tid * 4 + 2];
                *(i32x4*)(a.ws + WS_ROUTE + (size_t)(rb + tid) * 16) = o; }
            __syncthreads();
        }
    }
}
DI void moe_offsets(const unsigned* cnt, int (&off)[9]) {
    int o = 0;
#pragma unroll
    for (int e = 0; e < 8; ++e) { off[e] = o; const int c = (int)__hip_atomic_load(cnt + 64 * e, RLX_AGENT); o += ((c + 255) >> 8) << 8; }
    off[8] = o;
}
DI void moe_permute(const Ctx& a, unsigned* cnt, LAS unsigned char* lds, int tid, int lane, int wave) {
    LAS int* BASE = (LAS int*)lds;
    LAS int* TOT = BASE + 2048;
    const int* BC = (const int*)(a.ws + WS_BLKCNT);
    {
        LAS int* CNT = TOT + 64;
        *(LAS i32x4*)(CNT + 4 * tid) = *(const i32x4*)(BC + 4 * tid);
        __syncthreads();
        int c[4], s = 0;
#pragma unroll
        for (int i = 0; i < 4; ++i) { c[i] = CNT[(4 * lane + i) * 8 + wave]; s += c[i]; }
        int incl = s;
#pragma unroll
        for (int o = 1; o < 64; o <<= 1) { const int t = __builtin_amdgcn_ds_bpermute((lane - o) << 2, incl); if (lane >= o) incl += t; }
        int run = incl - s;
#pragma unroll
        for (int i = 0; i < 4; ++i) { BASE[(4 * lane + i) * 8 + wave] = run; run += c[i]; }
        if (lane == 63) { TOT[wave] = incl; if (blockIdx.x == 0) __hip_atomic_store(cnt + 64 * wave, (unsigned)incl, RLX_AGENT); }
    }
    __syncthreads();
    int off[9]; { int o = 0;
#pragma unroll
        for (int e = 0; e < 8; ++e) { off[e] = o; o += ((TOT[e] + 255) >> 8) << 8; }
        off[8] = o; }
    (void)lane; (void)wave;
    int* RI = (int*)(a.ws + WS_ROWINFO);
    for (int t = blockIdx.x * NTHREADS + tid; t < T; t += gridDim.x * NTHREADS) {
        const i32x4 r = *(const i32x4*)(a.ws + WS_ROUTE + (size_t)t * 16);
        const int rx = r.x, ry = r.y, rz = r.z, rw = r.w; const int e0 = rx & 255, e1 = (rx >> 8) & 255; const float p0 = __builtin_bit_cast(float, rw);
        int d0 = ry + BASE[(t >> 6) * 8 + e0], d1 = rz + BASE[(t >> 6) * 8 + e1];
#pragma unroll
        for (int e = 0; e < 8; ++e) { d0 += (e0 == e) ? off[e] : 0; d1 += (e1 == e) ? off[e] : 0; }
        u32x2 w0, w1; w0.x = (unsigned)t; w0.y = __builtin_bit_cast(unsigned, p0); w1.x = (unsigned)t | (1u << 30); w1.y = __builtin_bit_cast(unsigned, 1.0f - p0);
        *(u32x2*)(RI + 2 * d0) = w0; *(u32x2*)(RI + 2 * d1) = w1;
    }
    int neg1 = -1; asm volatile("" : "+v"(neg1));
#pragma unroll
    for (int e = 0; e < 8; ++e) {
        const int c = TOT[e], beg = off[e] + c, end = off[e + 1];
        for (int r = beg + blockIdx.x * NTHREADS + tid; r < end; r += gridDim.x * NTHREADS) { RI[2 * r] = neg1; RI[2 * r + 1] = 0; }
    }
}

struct MixArgs { const float* gaw; const float* gab; const float* gnw; const float* convw; const float* convb; const float* dtb; const float* alog; const float* dskip; const float* snw; };

DI void gla_load_aw(const MixArgs& m, int tid, float (&aw)[17]) {
    const int hd = tid & 255;
#pragma unroll
    for (int r = 0; r < 16; ++r) aw[r] = m.gaw[r * 256 + hd];
    aw[16] = m.gab[hd];
}
DI float gla_cumsum(const float (&aw)[17], const LAS float* ALR, LAS float* HTOT, int tid, float (&cs)[32]) {
    const int hd = tid & 255, half = tid >> 8;
    const float ab = aw[16];
    float run = 0.f;
    f32x2 aw2[8];
#pragma unroll
    for (int q = 0; q < 8; ++q) aw2[q] = (f32x2){aw[2 * q], aw[2 * q + 1]};
#pragma unroll
    for (int jj = 0; jj < 32; ++jj) { const LAS f32x4* ar = (const LAS f32x4*)(ALR + (half * 32 + jj) * 16); f32x2 x2 = {ab, 0.f};
#pragma unroll
        for (int q = 0; q < 4; ++q) { const f32x4 v = ar[q]; x2 += (f32x2){v[0], v[1]} * aw2[2 * q]; x2 += (f32x2){v[2], v[3]} * aw2[2 * q + 1]; }
        const float x = x2[0] + x2[1];
        run += logsigmoid_f(x) * (1.0f / 16.0f); cs[jj] = run; }
    HTOT[half * 256 + hd] = run;
    __syncthreads();
    const float t0 = HTOT[hd], t1 = HTOT[256 + hd];
    if (half) {
#pragma unroll
        for (int jj = 0; jj < 32; ++jj) cs[jj] += t0; }
    return t0 + t1;
}
DI void ssd_dt_cum(const MixArgs& m, const float* SMALL, int r0, LAS float* DT, LAS float* CUM, int lane, int wave, float& cum_last) {
    const int h = wave;
    const float dt = softplus_f(SMALL[(size_t)(r0 + lane) * 32 + 16 + h] + m.dtb[h]);
    const float av = -__expf(m.alog[h]);
    float c = dt * av;
#pragma unroll
    for (int o = 1; o < 64; o <<= 1) { const float t = shfl_idx(c, lane - o); if (lane >= o) c += t; }
    DT[lane * 8 + h] = dt; CUM[lane * 8 + h] = c;
    cum_last = shfl_idx(c, 63);
}

DI MixArgs mk_mix(const Ctx& a, int l) {
    MixArgs m; m.gaw = INP(I_GAW) + (size_t)l * 16 * 256; m.gab = INP(I_GAB) + (size_t)l * 256; m.gnw = INP(I_GNW) + (size_t)l * 128; m.convw = INP(I_CONVW) + (size_t)l * 4 * 768; m.convb = INP(I_CONVB) + (size_t)l * 768;
    m.dtb = INP(I_DTB) + (size_t)l * 8; m.alog = INP(I_ALOG) + (size_t)l * 8; m.dskip = INP(I_DSKIP) + (size_t)l * 8; m.snw = INP(I_SNW) + (size_t)l * 512; return m;
}
DI void phase_s1(const Ctx& a, const MixArgs& m, LAS unsigned char* lds, int tid, int lane, int wave) {
    const bf16* PROJ = (const bf16*)(a.ws + WS_PROJ); const float* SMALL = (const float*)(a.ws + WS_SMALL);
    bf16* XBC = (bf16*)(a.ws + WS_XBC);
    bf16* CG = (bf16*)(a.ws + WS_CONTRG); bf16* CS = (bf16*)(a.ws + WS_CONTRS); float* DECG = (float*)(a.ws + WS_DECG); float* DECS = (float*)(a.ws + WS_DECS);
    const int g = lane >> 4, fr = lane & 15;
#ifndef MK_S1_REP_G
#define MK_S1_REP_G 1
#endif
#ifndef MK_S1_REP_S
#define MK_S1_REP_S 1
#endif
    for (int rep_g = 0; rep_g < MK_S1_REP_G; ++rep_g)
    for (int u = blockIdx.x; u < NUNIT; u += gridDim.x) {
        const int b = u / NCH, c = u % NCH, r0 = b * SEQ + c * CH;
        {
            LAS float* ALR = (LAS float*)lds;
            LAS unsigned char* KT = lds + 4096;
            LAS unsigned char* VN = lds + 40960;
            LAS float* HTOT = (LAS float*)(lds + 107520);
            LAS unsigned char* KR = lds + 109568;
            float aw[17];
            {
              f32x4 ta = {0.f, 0.f, 0.f, 0.f}; u32x4 tv[8], tk[4];
              gla_load_aw(m, tid, aw);
              if (tid < 256) ta = *(const f32x4*)(SMALL + (size_t)(r0 + (tid >> 2)) * 32 + 4 * (tid & 3));
#pragma unroll
              for (int i = 0; i < 8; ++i) { const int id = tid + NTHREADS * i, row = id >> 6, cp = id & 63; tv[i] = *(const u32x4*)(PROJ + (size_t)(r0 + row) * PROJ_LD + C_V + cp * 8); }
#pragma unroll
              for (int i = 0; i < 4; ++i) { const int id = tid + NTHREADS * i, row = id >> 5, cp = id & 31; tk[i] = *(const u32x4*)(PROJ + (size_t)(r0 + row) * PROJ_LD + C_K + cp * 8); }
              PIN8(tv); PIN4(tk); asm volatile("" : "+v"(ta));
              if (tid < 256) *(LAS f32x4*)(ALR + (tid >> 2) * 16 + 4 * (tid & 3)) = ta;
#pragma unroll
              for (int i = 0; i < 8; ++i) { const int id = tid + NTHREADS * i, row = id >> 6, cp = id & 63; *(LAS u32x4*)(VN + row * 1040 + cp * 16) = tv[i]; }
#pragma unroll
              for (int i = 0; i < 4; ++i) { const int id = tid + NTHREADS * i, row = id >> 5, cp = id & 31; *(LAS u32x4*)(KR + row * 528 + cp * 16) = tk[i]; } }
            __syncthreads();
            float cs[32];
            const float blast = gla_cumsum(aw, ALR, HTOT, tid, cs);
            const int hd = tid & 255, half = tid >> 8;
            if (half == 0) DECG[(size_t)u * 256 + hd] = __expf(blast);
#pragma unroll
            for (int j8 = 0; j8 < 4; ++j8) { float kt[8];
#pragma unroll
                for (int e = 0; e < 8; ++e) { const int jj = j8 * 8 + e; const float kv = bf2f(*(const LAS bf16*)(KR + (half * 32 + jj) * 528 + hd * 2)); kt[e] = kv * __expf(blast - cs[jj]); }
                u32x4 w; w.x = pk2(kt[0], kt[1]); w.y = pk2(kt[2], kt[3]); w.z = pk2(kt[4], kt[5]); w.w = pk2(kt[6], kt[7]);
                *(LAS u32x4*)(KT + hd * 144 + (half * 32 + j8 * 8) * 2) = w; }
            __syncthreads();
            const int h = wave >> 1, vh = wave & 1;
            f32x4 acc[4][4];
#pragma unroll
            for (int dt = 0; dt < 4; ++dt)
#pragma unroll
                for (int vt = 0; vt < 4; ++vt) acc[dt][vt] = (f32x4){0.f, 0.f, 0.f, 0.f};
#pragma unroll
            for (int ks = 0; ks < 2; ++ks) { bf16x8 af[4], bfr[4];
#pragma unroll
                for (int dt = 0; dt < 4; ++dt) af[dt] = frag_rowk(KT, 144, h * 64 + 16 * dt, 32 * ks, lane);
#pragma unroll
                for (int vt = 0; vt < 4; ++vt) bfr[vt] = frag_tr(VN, 1040, 32 * ks, h * 128 + vh * 64 + 16 * vt, lane);
#pragma unroll
                for (int dt = 0; dt < 4; ++dt)
#pragma unroll
                    for (int vt = 0; vt < 4; ++vt) acc[dt][vt] = MFMA16(af[dt], bfr[vt], acc[dt][vt]); }
            bf16* cg = CG + ((size_t)u * 4 + h) * 8192;
#pragma unroll
            for (int dt = 0; dt < 4; ++dt)
#pragma unroll
                for (int vt = 0; vt < 4; ++vt) { u32x2 w; w.x = pk2(acc[dt][vt][0], acc[dt][vt][1]); w.y = pk2(acc[dt][vt][2], acc[dt][vt][3]); *(u32x2*)(cg + (vh * 64 + 16 * vt + fr) * 64 + 16 * dt + 4 * g) = w; }
            __syncthreads();
        }
    }
    for (int rep_s = 0; rep_s < MK_S1_REP_S; ++rep_s)
    for (int u = blockIdx.x; u < NUNIT; u += gridDim.x) {
        const int b = u / NCH, c = u % NCH, r0 = b * SEQ + c * CH; (void)b; (void)c;
        {
            LAS float* DT = (LAS float*)lds;
            LAS float* CUM = (LAS float*)(lds + 2048);
            LAS float* WJ = (LAS float*)(lds + 4096);
            LAS unsigned char* XW = lds + 8192;
            LAS unsigned char* BN = lds + 74752;
            float cum_last; ssd_dt_cum(m, SMALL, r0, DT, CUM, lane, wave, cum_last);
            WJ[lane * 8 + wave] = DT[lane * 8 + wave] * __expf(cum_last - CUM[lane * 8 + wave]);
            if (lane == 0) DECS[(size_t)u * 8 + wave] = __expf(cum_last);
            __syncthreads();
            for (int it = tid; it < 768; it += NTHREADS) {
                const int cg8 = it % 96, tb = it / 96, ch0 = cg8 * 8, j0 = tb * 8;
                f32x2 wgt[4][4], bias[4];
#pragma unroll
                for (int k = 0; k < 4; ++k) { const f32x4 w0 = *(const f32x4*)(m.convw + k * 768 + ch0), w1 = *(const f32x4*)(m.convw + k * 768 + ch0 + 4);
                    wgt[k][0] = (f32x2){w0[0], w0[1]}; wgt[k][1] = (f32x2){w0[2], w0[3]}; wgt[k][2] = (f32x2){w1[0], w1[1]}; wgt[k][3] = (f32x2){w1[2], w1[3]}; }
                { const f32x4 b0 = *(const f32x4*)(m.convb + ch0), b1 = *(const f32x4*)(m.convb + ch0 + 4); bias[0] = (f32x2){b0[0], b0[1]}; bias[1] = (f32x2){b0[2], b0[3]}; bias[2] = (f32x2){b1[0], b1[1]}; bias[3] = (f32x2){b1[2], b1[3]}; }
                u32x4 raw[11];
#pragma unroll
                for (int r = 0; r < 11; ++r) { const int j = j0 - 3 + r; const bool ok = (c * CH + j) >= 0;
                    raw[r] = ok ? *(const u32x4*)(PROJ + (size_t)(r0 + j) * PROJ_LD + C_XS + ch0) : (u32x4){0u, 0u, 0u, 0u}; }
#pragma unroll
                for (int jj = 0; jj < 8; ++jj) { f32x2 o[4];
#pragma unroll
                    for (int i = 0; i < 4; ++i) o[i] = bias[i];
#pragma unroll
                    for (int k = 0; k < 4; ++k) { const u32x4 rv = raw[jj + k];
                        o[0] += wgt[k][0] * (f32x2){bflo(rv.x), bfhi(rv.x)}; o[1] += wgt[k][1] * (f32x2){bflo(rv.y), bfhi(rv.y)};
                        o[2] += wgt[k][2] * (f32x2){bflo(rv.z), bfhi(rv.z)}; o[3] += wgt[k][3] * (f32x2){bflo(rv.w), bfhi(rv.w)}; }
#pragma unroll
                    for (int i = 0; i < 4; ++i) { const f32x2 den = (f32x2){__expf(-o[i][0]), __expf(-o[i][1])} + 1.0f; o[i] = o[i] * (f32x2){__builtin_amdgcn_rcpf(den[0]), __builtin_amdgcn_rcpf(den[1])}; }
                    const int j = j0 + jj;
                    u32x4 w; w.x = pk2(o[0][0], o[0][1]); w.y = pk2(o[1][0], o[1][1]); w.z = pk2(o[2][0], o[2][1]); w.w = pk2(o[3][0], o[3][1]);
                    *(u32x4*)(XBC + (size_t)(r0 + j) * 768 + ch0) = w;
                    if (ch0 < 512) { const float wj = WJ[j * 8 + (ch0 >> 6)];
                        const f32x2 x0 = (f32x2){bflo(w.x), bfhi(w.x)} * wj, x1 = (f32x2){bflo(w.y), bfhi(w.y)} * wj, x2 = (f32x2){bflo(w.z), bfhi(w.z)} * wj, x3 = (f32x2){bflo(w.w), bfhi(w.w)} * wj;
                        u32x4 x; x.x = pk2(x0[0], x0[1]); x.y = pk2(x1[0], x1[1]); x.z = pk2(x2[0], x2[1]); x.w = pk2(x3[0], x3[1]);
                        *(LAS u32x4*)(XW + j * 1040 + ch0 * 2) = x; }
                    else if (ch0 < 640) *(LAS u32x4*)(BN + j * 272 + (ch0 - 512) * 2) = w; }
            }
            __syncthreads();
            const int h = wave, gi = h >> 2;
            f32x4 acc[4][4];
#pragma unroll
            for (int st = 0; st < 4; ++st)
#pragma unroll
                for (int pt = 0; pt < 4; ++pt) acc[st][pt] = (f32x4){0.f, 0.f, 0.f, 0.f};
#pragma unroll
            for (int ks = 0; ks < 2; ++ks) { bf16x8 af[4], bfr[4];
#pragma unroll
                for (int st = 0; st < 4; ++st) af[st] = frag_tr(BN, 272, 32 * ks, gi * 64 + 16 * st, lane);
#pragma unroll
                for (int pt = 0; pt < 4; ++pt) bfr[pt] = frag_tr(XW, 1040, 32 * ks, h * 64 + 16 * pt, lane);
#pragma unroll
                for (int st = 0; st < 4; ++st)
#pragma unroll
                    for (int pt = 0; pt < 4; ++pt) acc[st][pt] = MFMA16(af[st], bfr[pt], acc[st][pt]); }
            bf16* csp = CS + ((size_t)u * 8 + h) * 4096;
#pragma unroll
            for (int st = 0; st < 4; ++st)
#pragma unroll
                for (int pt = 0; pt < 4; ++pt) { u32x2 w; w.x = pk2(acc[st][pt][0], acc[st][pt][1]); w.y = pk2(acc[st][pt][2], acc[st][pt][3]); *(u32x2*)(csp + (16 * pt + fr) * 64 + 16 * st + 4 * g) = w; }
            __syncthreads();
        }
    }
}

DI void phase_scan(const Ctx& a, int tid) {
    const bf16* CG = (const bf16*)(a.ws + WS_CONTRG); const bf16* CS = (const bf16*)(a.ws + WS_CONTRS);
    const float* DECG = (const float*)(a.ws + WS_DECG); const float* DECS = (const float*)(a.ws + WS_DECS);
    bf16* SG = (bf16*)(a.ws + WS_SPREVG); bf16* SS = (bf16*)(a.ws + WS_SPREVS);
    for (int gt = blockIdx.x * NTHREADS + tid; gt < 131072; gt += gridDim.x * NTHREADS) {
        const bf16* cp; const float* dp; bf16* sp; size_t cstep, dstep;
        if (gt < 65536) {
            const int b = gt >> 15, h = (gt >> 13) & 3, vd = gt & 8191, d = gt & 63;
            cp = CG + ((size_t)(b * NCH) * 4 + h) * 8192 + vd; dp = DECG + (size_t)(b * NCH) * 256 + h * 64 + d; sp = SG + ((size_t)(b * NCH) * 4 + h) * 8192 + vd; cstep = 4 * 8192; dstep = 256;
        } else {
            const int q = gt - 65536, b = q >> 15, h = (q >> 12) & 7, ps = q & 4095;
            cp = CS + ((size_t)(b * NCH) * 8 + h) * 4096 + ps; dp = DECS + (size_t)(b * NCH) * 8 + h; sp = SS + ((size_t)(b * NCH) * 8 + h) * 4096 + ps; cstep = 8 * 4096; dstep = 8;
        }
        unsigned cv[8], cn[8]; float dv[8], dn[8];
#pragma unroll
        for (int i = 0; i < 8; ++i) { cv[i] = cp[(size_t)i * cstep]; dv[i] = dp[(size_t)i * dstep]; }
        float s = 0.f;
#pragma unroll 1
        for (int n = 0; n < NCH; n += 8) {
            const int nn = (n + 8 < NCH) ? n + 8 : n;
#pragma unroll
            for (int i = 0; i < 8; ++i) { cn[i] = cp[(size_t)(nn + i) * cstep]; dn[i] = dp[(size_t)(nn + i) * dstep]; }
            PIN8(cn); PIN8(dn);
#pragma unroll
            for (int i = 0; i < 8; ++i) { sp[(size_t)(n + i) * cstep] = (bf16)f2bf(s); s = dv[i] * s + bf2f(cv[i]); }
#pragma unroll
            for (int i = 0; i < 8; ++i) { cv[i] = cn[i]; dv[i] = dn[i]; }
        }
    }
}

DI void phase_s3(const Ctx& a, const MixArgs& m, LAS unsigned char* lds, int tid, int lane, int wave) {
    const bf16* PROJ = (const bf16*)(a.ws + WS_PROJ); const float* SMALL = (const float*)(a.ws + WS_SMALL);
    const bf16* XBC = (const bf16*)(a.ws + WS_XBC);
    const bf16* SG = (const bf16*)(a.ws + WS_SPREVG); const bf16* SS = (const bf16*)(a.ws + WS_SPREVS);
    bf16* MG = (bf16*)(a.ws + WS_MERGED);
    const int g = lane >> 4, fr = lane & 15;
#ifndef MK_S3_REP_G
#define MK_S3_REP_G 1
#endif
#ifndef MK_S3_REP_S
#define MK_S3_REP_S 1
#endif
    for (int rep_g = 0; rep_g < MK_S3_REP_G; ++rep_g)
    for (int u = blockIdx.x; u < NUNIT; u += gridDim.x) {
        const int b = u / NCH, c = u % NCH, r0 = b * SEQ + c * CH;
        {
            LAS float* ALR = (LAS float*)lds;
            LAS unsigned char* QE = lds + 4096;
            LAS unsigned char* KE = lds + 37888;
            LAS unsigned char* VN = lds + 74752;
            LAS float* HTOT = (LAS float*)(lds + 141312);
            float aw[17];
            {
              f32x4 ta = {0.f, 0.f, 0.f, 0.f}; u32x4 tv[8], tq[8];
              gla_load_aw(m, tid, aw);
              if (tid < 256) ta = *(const f32x4*)(SMALL + (size_t)(r0 + (tid >> 2)) * 32 + 4 * (tid & 3));
#pragma unroll
              for (int i = 0; i < 8; ++i) { const int id = tid + NTHREADS * i, row = id >> 6, cp = id & 63; tv[i] = *(const u32x4*)(PROJ + (size_t)(r0 + row) * PROJ_LD + C_V + cp * 8); }
#pragma unroll
              for (int i = 0; i < 4; ++i) { const int id = tid + NTHREADS * i, row = id >> 5, cp = id & 31;
                  tq[i] = *(const u32x4*)(PROJ + (size_t)(r0 + row) * PROJ_LD + C_Q + cp * 8); tq[4 + i] = *(const u32x4*)(PROJ + (size_t)(r0 + row) * PROJ_LD + C_K + cp * 8); }
              PIN8(tv); PIN8(tq); asm volatile("" : "+v"(ta));
              if (tid < 256) *(LAS f32x4*)(ALR + (tid >> 2) * 16 + 4 * (tid & 3)) = ta;
#pragma unroll
              for (int i = 0; i < 8; ++i) { const int id = tid + NTHREADS * i, row = id >> 6, cp = id & 63; *(LAS u32x4*)(VN + row * 1040 + cp * 16) = tv[i]; }
#pragma unroll
              for (int i = 0; i < 4; ++i) { const int id = tid + NTHREADS * i, row = id >> 5, cp = id & 31;
                  *(LAS u32x4*)(QE + row * 528 + cp * 16) = tq[i]; *(LAS u32x4*)(KE + row * 528 + cp * 16) = tq[4 + i]; } }
            __syncthreads();
            {
                float cs[32];
                (void)gla_cumsum(aw, ALR, HTOT, tid, cs);
                const int hd = tid & 255, half = tid >> 8;
#pragma unroll
                for (int jj = 0; jj < 32; ++jj) { const int j = half * 32 + jj;
                    const float qv = bf2f(*(const LAS bf16*)(QE + j * 528 + hd * 2)), kv = bf2f(*(const LAS bf16*)(KE + j * 528 + hd * 2));
                    *(LAS bf16*)(QE + j * 528 + hd * 2) = (bf16)f2bf(qv * 0.125f * __expf(cs[jj]));
                    *(LAS bf16*)(KE + j * 528 + hd * 2) = (bf16)f2bf(kv * __expf(-cs[jj])); }
            }
            __syncthreads();
            const int h = wave >> 1, ih = wave & 1, i0 = 32 * ih;
            bf16x8 qf[2][2];
#pragma unroll
            for (int it = 0; it < 2; ++it)
#pragma unroll
                for (int ks = 0; ks < 2; ++ks) qf[it][ks] = frag_rowk(QE, 528, i0 + 16 * it, h * 64 + 32 * ks, lane);
            f32x4 at[4][2];
#pragma unroll
            for (int jt = 0; jt < 4; ++jt)
#pragma unroll
                for (int it = 0; it < 2; ++it) at[jt][it] = (f32x4){0.f, 0.f, 0.f, 0.f};
#pragma unroll
            for (int jt = 0; jt < 4; ++jt) {
                if (jt < 2 * (ih + 1)) {
#pragma unroll
                    for (int ks = 0; ks < 2; ++ks) { const bf16x8 kf = frag_rowk(KE, 528, 16 * jt, h * 64 + 32 * ks, lane);
#pragma unroll
                        for (int it = 0; it < 2; ++it) at[jt][it] = MFMA16(kf, qf[it][ks], at[jt][it]); } } }
            __syncthreads();
            LAS unsigned char* PW = KE + wave * 4608;
#pragma unroll
            for (int jt = 0; jt < 4; ++jt)
#pragma unroll
                for (int it = 0; it < 2; ++it) { const int i = i0 + 16 * it + fr; float v[4];
#pragma unroll
                    for (int r = 0; r < 4; ++r) { const int j = 16 * jt + 4 * g + r; v[r] = (j <= i) ? at[jt][it][r] : 0.f; }
                    u32x2 w; w.x = pk2(v[0], v[1]); w.y = pk2(v[2], v[3]);
                    *(LAS u32x2*)(PW + (16 * it + fr) * 144 + (16 * jt + 4 * g) * 2) = w; }
            f32x4 oa[8][2];
#pragma unroll
            for (int vt = 0; vt < 8; ++vt)
#pragma unroll
                for (int it = 0; it < 2; ++it) oa[vt][it] = (f32x4){0.f, 0.f, 0.f, 0.f};
            const bf16* sg = SG + ((size_t)u * 4 + h) * 8192;
#pragma unroll
            for (int ks = 0; ks < 2; ++ks) { bf16x8 sf[8];
#pragma unroll
                for (int vt = 0; vt < 8; ++vt) sf[vt] = *(const bf16x8*)(sg + (16 * vt + fr) * 64 + 32 * ks + 8 * g);
#pragma unroll
                for (int vt = 0; vt < 8; ++vt)
#pragma unroll
                    for (int it = 0; it < 2; ++it) oa[vt][it] = MFMA16(sf[vt], qf[it][ks], oa[vt][it]); }
#pragma unroll
            for (int ks = 0; ks < 2; ++ks) {
                if (ks <= ih) { bf16x8 pf[2];
#pragma unroll
                    for (int it = 0; it < 2; ++it) pf[it] = frag_rowk(PW, 144, 16 * it, 32 * ks, lane);
#pragma unroll
                    for (int vt = 0; vt < 8; ++vt) { const bf16x8 vf = frag_tr(VN, 1040, 32 * ks, h * 128 + 16 * vt, lane);
#pragma unroll
                        for (int it = 0; it < 2; ++it) oa[vt][it] = MFMA16(vf, pf[it], oa[vt][it]); } } }
#pragma unroll
            for (int it = 0; it < 2; ++it) { float ss = 0.f;
#pragma unroll
                for (int vt = 0; vt < 8; ++vt) ss += (oa[vt][it][0] * oa[vt][it][0] + oa[vt][it][1] * oa[vt][it][1]) + (oa[vt][it][2] * oa[vt][it][2] + oa[vt][it][3] * oa[vt][it][3]);
                ss += shfl_xor_l(ss, 16, lane); ss += shfl_xor_l(ss, 32, lane);
                const float rstd = __builtin_amdgcn_rsqf(ss * (1.0f / 128.0f) + EPS);
                const size_t row = (size_t)(r0 + i0 + 16 * it + fr);
                f32x4 nwv[8]; u32x2 gtv[8];
#pragma unroll
                for (int vt = 0; vt < 8; ++vt) { const int vc = 16 * vt + 4 * g; nwv[vt] = *(const f32x4*)(m.gnw + vc); gtv[vt] = *(const u32x2*)(PROJ + row * PROJ_LD + C_G + h * 128 + vc); }
#pragma unroll
                for (int vt = 0; vt < 8; ++vt) { const int vc = 16 * vt + 4 * g; const f32x4 nw = nwv[vt];
                    const u32x2 gt = gtv[vt];
                    const f32x4 o = oa[vt][it]; u32x2 w;
                    w.x = pk2(o[0] * rstd * nw[0] * silu_f(bflo(gt.x)), o[1] * rstd * nw[1] * silu_f(bfhi(gt.x)));
                    w.y = pk2(o[2] * rstd * nw[2] * silu_f(bflo(gt.y)), o[3] * rstd * nw[3] * silu_f(bfhi(gt.y)));
                    *(u32x2*)(MG + row * D + h * 128 + vc) = w; } }
            __syncthreads();
        }
    }
    for (int rep_s = 0; rep_s < MK_S3_REP_S; ++rep_s)
    for (int u = blockIdx.x; u < NUNIT; u += gridDim.x) {
        const int b = u / NCH, c = u % NCH, r0 = b * SEQ + c * CH; (void)b; (void)c;
        {
            LAS float* DT = (LAS float*)lds;
            LAS float* CUM = (LAS float*)(lds + 2048);
            LAS float* RED = (LAS float*)(lds + 4096);
            LAS unsigned char* XS = lds + 8192;
            LAS unsigned char* BN = lds + 74752;
            LAS unsigned char* CN = lds + 92160;
            LAS unsigned char* PW = lds + 109568 + wave * 4608;
            float cum_last; ssd_dt_cum(m, SMALL, r0, DT, CUM, lane, wave, cum_last);
            { u32x4 ta[8], tb[4];
#pragma unroll
              for (int i = 0; i < 12; ++i) { const int id = tid + NTHREADS * i, row = id / 96, cp = id % 96; const u32x4 v = *(const u32x4*)(XBC + (size_t)(r0 + row) * 768 + cp * 8); if (i < 8) ta[i] = v; else tb[i - 8] = v; }
              PIN8(ta); PIN4(tb);
#pragma unroll
              for (int i = 0; i < 12; ++i) { const int id = tid + NTHREADS * i, row = id / 96, cp = id % 96;
                  LAS unsigned char* dst = cp < 64 ? XS + row * 1040 + cp * 16 : (cp < 80 ? BN + row * 272 + (cp - 64) * 16 : CN + row * 272 + (cp - 80) * 16);
                  *(LAS u32x4*)dst = i < 8 ? ta[i] : tb[i - 8]; } }
            __syncthreads();
            const int h = wave, gi = h >> 2;
            const float dsk = m.dskip[h];
            const bf16* ss = SS + ((size_t)u * 8 + h) * 4096;
            f32x4 snwv[4];
#pragma unroll
            for (int pt = 0; pt < 4; ++pt) snwv[pt] = *(const f32x4*)(m.snw + h * 64 + 16 * pt + 4 * g);
#pragma unroll 1
            for (int ih = 0; ih < 2; ++ih) {
                bf16x8 cf[2][2];
#pragma unroll
                for (int it = 0; it < 2; ++it)
#pragma unroll
                    for (int ks = 0; ks < 2; ++ks) cf[it][ks] = frag_rowk(CN, 272, 32 * ih + 16 * it, gi * 64 + 32 * ks, lane);
                float cumi[2];
#pragma unroll
                for (int it = 0; it < 2; ++it) cumi[it] = CUM[(32 * ih + 16 * it + fr) * 8 + h];
#pragma unroll
                for (int jt = 0; jt < 4; ++jt) {
                    f32x4 gt[2] = {{0.f, 0.f, 0.f, 0.f}, {0.f, 0.f, 0.f, 0.f}};
                    if (jt < 2 * (ih + 1)) {
#pragma unroll
                        for (int ks = 0; ks < 2; ++ks) { const bf16x8 bfr = frag_rowk(BN, 272, 16 * jt, gi * 64 + 32 * ks, lane);
#pragma unroll
                            for (int it = 0; it < 2; ++it) gt[it] = MFMA16(bfr, cf[it][ks], gt[it]); } }
                    float cj[4], dj[4];
#pragma unroll
                    for (int r = 0; r < 4; ++r) { const int j = 16 * jt + 4 * g + r; cj[r] = CUM[j * 8 + h]; dj[r] = DT[j * 8 + h]; }
#pragma unroll
                    for (int it = 0; it < 2; ++it) { const int i = 32 * ih + 16 * it + fr; float v[4];
#pragma unroll
                        for (int r = 0; r < 4; ++r) { const int j = 16 * jt + 4 * g + r; v[r] = (j <= i) ? gt[it][r] * __expf(cumi[it] - cj[r]) * dj[r] : 0.f; }
                        u32x2 w; w.x = pk2(v[0], v[1]); w.y = pk2(v[2], v[3]);
                        *(LAS u32x2*)(PW + (16 * it + fr) * 144 + (16 * jt + 4 * g) * 2) = w; }
                }
                f32x4 ya[4][2];
#pragma unroll
                for (int pt = 0; pt < 4; ++pt)
#pragma unroll
                    for (int it = 0; it < 2; ++it) ya[pt][it] = (f32x4){0.f, 0.f, 0.f, 0.f};
#pragma unroll
                for (int ks = 0; ks < 2; ++ks)
#pragma unroll
                    for (int pt = 0; pt < 4; ++pt) { const bf16x8 sf = *(const bf16x8*)(ss + (16 * pt + fr) * 64 + 32 * ks + 8 * g);
#pragma unroll
                        for (int it = 0; it < 2; ++it) ya[pt][it] = MFMA16(sf, cf[it][ks], ya[pt][it]); }
#pragma unroll
                for (int it = 0; it < 2; ++it) { const float ec = __expf(cumi[it]);
#pragma unroll
                    for (int pt = 0; pt < 4; ++pt) ya[pt][it] = ya[pt][it] * ec; }
#pragma unroll
                for (int ks = 0; ks < 2; ++ks) {
                    if (ks <= ih) { bf16x8 pf[2];
#pragma unroll
                        for (int it = 0; it < 2; ++it) pf[it] = frag_rowk(PW, 144, 16 * it, 32 * ks, lane);
#pragma unroll
                        for (int pt = 0; pt < 4; ++pt) { const bf16x8 xf = frag_tr(XS, 1040, 32 * ks, h * 64 + 16 * pt, lane);
#pragma unroll
                            for (int it = 0; it < 2; ++it) ya[pt][it] = MFMA16(xf, pf[it], ya[pt][it]); } } }
                u32x2 zvv[2][4];
#pragma unroll
                for (int it = 0; it < 2; ++it)
#pragma unroll
                    for (int pt = 0; pt < 4; ++pt) zvv[it][pt] = *(const u32x2*)(PROJ + (size_t)(r0 + 32 * ih + 16 * it + fr) * PROJ_LD + C_Z + h * 64 + 16 * pt + 4 * g);
#pragma unroll
                for (int it = 0; it < 2; ++it) { const int i = 32 * ih + 16 * it + fr; float sq = 0.f;
#pragma unroll
                    for (int pt = 0; pt < 4; ++pt) { const int pc = h * 64 + 16 * pt + 4 * g;
                        const u32x2 xv = *(const LAS u32x2*)(XS + i * 1040 + pc * 2); const u32x2 zv = zvv[it][pt];
                        f32x4 y = ya[pt][it];
                        y[0] = (y[0] + dsk * bflo(xv.x)) * silu_f(bflo(zv.x)); y[1] = (y[1] + dsk * bfhi(xv.x)) * silu_f(bfhi(zv.x));
                        y[2] = (y[2] + dsk * bflo(xv.y)) * silu_f(bflo(zv.y)); y[3] = (y[3] + dsk * bfhi(xv.y)) * silu_f(bfhi(zv.y));
                        ya[pt][it] = y; sq += (y[0] * y[0] + y[1] * y[1]) + (y[2] * y[2] + y[3] * y[3]); }
                    sq += shfl_xor_l(sq, 16, lane); sq += shfl_xor_l(sq, 32, lane);
                    if (g == 0) RED[h * 64 + i] = sq; }
                __syncthreads();
#pragma unroll
                for (int it = 0; it < 2; ++it) { const int i = 32 * ih + 16 * it + fr; float tot = 0.f;
#pragma unroll
                    for (int hh = 0; hh < 8; ++hh) tot += RED[hh * 64 + i];
                    const float rstd = __builtin_amdgcn_rsqf(tot * (1.0f / 512.0f) + EPS);
#pragma unroll
                    for (int pt = 0; pt < 4; ++pt) { const int pc = h * 64 + 16 * pt + 4 * g; const f32x4 nw = snwv[pt]; const f32x4 y = ya[pt][it];
                        u32x2 w; w.x = pk2(y[0] * rstd * nw[0], y[1] * rstd * nw[1]); w.y = pk2(y[2] * rstd * nw[2], y[3] * rstd * nw[3]);
                        *(u32x2*)(MG + (size_t)(r0 + i) * D + 512 + pc) = w; } }
            }
            __syncthreads();
        }
    }
}

constexpr int PH_FINAL = 41, N_PHASES = 42;
#ifndef MK_MASK
#define MK_MASK 0xffffffffu
#endif
#define SITE(n) (((MK_MASK) >> (n)) & 1u)
#define IN(k) (lo <= (k) && (k) < hi)
#define SEAM(k) do { if (hi > (k) + 1) { XcdBarrier b_ = bar; { GAS unsigned* bp_ = (GAS unsigned*)bar.bar; asm volatile("" : "+s"(bp_)); b_.bar = (unsigned*)bp_; } xcd_barrier(b_, tid); } } while (0)
#define PHASE_CTX int lane; asm volatile("v_mbcnt_lo_u32_b32 %0, -1, 0\n\tv_mbcnt_hi_u32_b32 %0, -1, %0" : "=v"(lane) : "s"(l)); int wave = wave_s, G = (int)gridDim.x, bid = (int)blockIdx.x; asm volatile("" : "+s"(wave), "+s"(G), "+s"(bid) : "s"(l)); const int tid = wave * 64 + lane; (void)G; (void)bid; Ctx a = a0; { GAS unsigned char* w_ = (GAS unsigned char*)a0.ws; asm volatile("" : "+s"(w_) : "s"(l)); a.ws = (unsigned char*)w_; } unsigned char* ws = a.ws; (void)ws; \
    float* MOD = (float*)(ws + WS_MOD); bf16* X = (bf16*)(ws + WS_X); bf16* H = (bf16*)(ws + WS_H); bf16* HTOK = (bf16*)(ws + WS_HTOK); bf16* Y2 = (bf16*)(ws + WS_Y2); bf16* PROJ = (bf16*)(ws + WS_PROJ); \
    bf16* MERGED = (bf16*)(ws + WS_MERGED); bf16* HID = (bf16*)(ws + WS_HID); const float* mod = MOD + (size_t)l * 2 * 6144; (void)X; (void)H; (void)HTOK; (void)Y2; (void)PROJ; (void)MERGED; (void)HID; (void)mod;

template <int l> DI void run_layer(const Ctx& a0, LAS unsigned char* lds, const int wave_s, const int lo, const int hi, const XcdBarrier& bar, const int dummy) {
        constexpr int pb = 1 + 10 * l, li = l >> 1; constexpr bool moe = (l & 1) != 0;
                if (SITE(1) && IN(pb + 0)) { PHASE_CTX
            NormArgs na; na.xin = (l == 0) ? INP(I_X) : nullptr; na.X = X; na.nw = INP(I_N1W) + (size_t)l * D; na.sc = mod + 1024; na.sh = mod; na.g2 = MOD + (size_t)(l ? l - 1 : 0) * 2 * 6144 + 5120; na.Y2 = Y2; na.H = H; na.out = nullptr; na.Y2b = nullptr; na.combine = (l == 2) && !(MK_DBG_SKIP & 4) && !dummy;
            norm_phase<0>(a, na, lds, tid, lane, wave, nullptr, nullptr); SEAM(pb + 0); }
        if (SITE(2) && IN(pb + 1)) { PHASE_CTX
            pg8::Gemm g{H, (const bf16*)(ws + WS_WIN) + (size_t)l * NPROJ_PAD * D, T, NPROJ_PAD, D}; pg8::StaticOrder S; S.init(T / 256, NPROJ_PAD / 256, G, bid, D / 64);
            pg8::EpiProj E{PROJ, (float*)(ws + WS_SMALL)};
            pg8::gemm_phase<pg8::EpiProj, pg8::StaticOrder, true, true>(lds, g, S, E, tid); SEAM(pb + 1); }
        if (SITE(3) && IN(pb + 2)) { PHASE_CTX const MixArgs m = mk_mix(a, l); phase_s1(a, m, lds, tid, lane, wave); SEAM(pb + 2); }
        if (SITE(4) && IN(pb + 3)) { PHASE_CTX phase_scan(a, tid); SEAM(pb + 3); }
        if (SITE(5) && IN(pb + 4)) { PHASE_CTX const MixArgs m = mk_mix(a, l); phase_s3(a, m, lds, tid, lane, wave); SEAM(pb + 4); }
        if (SITE(6) && IN(pb + 5)) { PHASE_CTX
            pg8::Gemm g{MERGED, (const bf16*)(ws + WS_WOUT) + (size_t)l * D * D, T, D, D}; pg8::StaticOrder S; S.init(T / 256, D / 256, G, bid, D / 64);
            pg8::EpiResid E{(l == 0) ? INP(I_X) : nullptr, X, mod + 2048, ((MK_DBG_SKIP & 1) || dummy) ? 0.f : 1.f};
            pg8::gemm_phase<pg8::EpiResid, pg8::StaticOrder, false, true>(lds, g, S, E, tid); SEAM(pb + 5); }
        if constexpr (!moe) {
            if (SITE(7) && IN(pb + 6)) { PHASE_CTX
                NormArgs na; na.xin = nullptr; na.X = X; na.nw = INP(I_N2W) + (size_t)l * D; na.sc = mod + 4096; na.sh = mod + 3072; na.g2 = mod + 5120; na.Y2 = Y2; na.H = H; na.out = nullptr; na.Y2b = nullptr; na.combine = 0;
                norm_phase<3>(a, na, lds, tid, lane, wave, nullptr, nullptr); SEAM(pb + 6); }
            if (SITE(8) && IN(pb + 7)) { PHASE_CTX
                pg8::Gemm g{H, (const bf16*)(ws + WS_WGU + (size_t)li * 2 * DFF * D), T, 2 * DFF, D / 2}; pg8::StaticOrder S; S.init(T / 256, 2 * DFF / 256, G, bid, D / 128);
                pg8::EpiSwiglu<true> E{HID};
                pg8::gemm_phase<pg8::EpiSwiglu<true>, pg8::StaticOrder, true, true, true>(lds, g, S, E, tid); SEAM(pb + 7); }
            if (SITE(9) && IN(pb + 8)) { PHASE_CTX
                pg8::Gemm g{HID, (const bf16*)(ws + WS_WD + (size_t)li * D * DFF), T, D, DFF / 2}; pg8::StaticOrder S; S.init(T / 256, D / 256, G, bid, DFF / 128);
                pg8::EpiResid E{nullptr, X, mod + 5120, ((MK_DBG_SKIP & 2) || dummy) ? 0.f : 1.f};
                pg8::gemm_phase<pg8::EpiResid, pg8::StaticOrder, false, true, true>(lds, g, S, E, tid); SEAM(pb + 8); }
        } else {
            if (SITE(10) && IN(pb + 6)) { PHASE_CTX
                NormArgs na; na.xin = nullptr; na.X = X; na.nw = INP(I_N2W) + (size_t)l * D; na.sc = mod + 4096; na.sh = mod + 3072; na.g2 = mod + 5120; na.Y2 = Y2; na.H = HTOK; na.out = nullptr; na.Y2b = nullptr; na.combine = 0;
                norm_phase<1>(a, na, lds, tid, lane, wave, INP(I_RW) + (size_t)li * D * NE, (unsigned*)(ws + WS_CTL) + CW_CNT + (dummy ? 4 : li) * 8 * 64); SEAM(pb + 6); }
            if (SITE(11) && IN(pb + 7)) { PHASE_CTX moe_permute(a, (unsigned*)(ws + WS_CTL) + CW_CNT + li * 8 * 64, lds, tid, lane, wave); SEAM(pb + 7); }
            if (SITE(12) && IN(pb + 8)) { PHASE_CTX
                int off[9]; moe_offsets((unsigned*)(ws + WS_CTL) + CW_CNT + li * 8 * 64, off); const int NT = off[8] >> 8;
                pg8::Gemm g{HTOK, (const bf16*)(ws + WS_MGU + (size_t)li * 8 * 2 * DFF * D), NT * 256, 2 * DFF, D / 2}; pg8::GatherOrder S; S.init(NT, 2 * DFF / 256, G, bid, D / 128);
                S.t1 = off[1] >> 8; S.t2 = off[2] >> 8; S.t3 = off[3] >> 8; S.t4 = off[4] >> 8; S.t5 = off[5] >> 8; S.t6 = off[6] >> 8; S.t7 = off[7] >> 8; S.estride = (size_t)2 * DFF * D;
                {
                    LAS unsigned* TOK = (LAS unsigned*)(lds + 131072); S.tok = TOK; const int* RI = (const int*)(ws + WS_ROWINFO);
                    int ti[16];
#pragma unroll
                    for (int i = 0; i < 16; ++i) { pg8::Unit uu; ti[i] = -1; if (tid < 256 && S.next(i, uu)) ti[i] = RI[2 * (uu.pm * 256 + tid)]; }
                    PIN8(ti); PIN8(ti + 8);
                    if (tid < 256) {
#pragma unroll
                        for (int i = 0; i < 16; ++i) TOK[i * 256 + tid] = ti[i] < 0 ? 0u : (unsigned)(ti[i] & 0x3fffffff) * (unsigned)D; }
                    __syncthreads(); }
                pg8::EpiSwiglu<true> E{HID};
                pg8::gemm_phase<pg8::EpiSwiglu<true>, pg8::GatherOrder, true, true, true>(lds, g, S, E, tid);
                if constexpr (l == 1) {
                    const int nwg = NT * (2 * DFF / 256), rounds = (nwg + G - 1) / G, fi = nwg - (rounds - 1) * G;
                    if (bid >= fi && fi < G) convert_moe_late(a, (bid - fi) * NWAVES + wave, (G - fi) * NWAVES, lane, 0, MOE_LATE_SPLIT); }
                SEAM(pb + 8); }
            if (SITE(13) && IN(pb + 9)) { PHASE_CTX
                int off[9]; moe_offsets((unsigned*)(ws + WS_CTL) + CW_CNT + li * 8 * 64, off); const int NT = off[8] >> 8;
                pg8::Gemm g{HID, (const bf16*)(ws + WS_MD + (size_t)li * 8 * D * DFF), NT * 256, D, DFF / 2}; pg8::StaticOrder S; S.init(NT, D / 256, G, bid, DFF / 128);
                S.t1 = off[1] >> 8; S.t2 = off[2] >> 8; S.t3 = off[3] >> 8; S.t4 = off[4] >> 8; S.t5 = off[5] >> 8; S.t6 = off[6] >> 8; S.t7 = off[7] >> 8; S.estride = (size_t)D * DFF;
                pg8::EpiMoeDown E{Y2, (const int*)(ws + WS_ROWINFO), (bf16*)(ws + WS_SKP), ws + WS_SKP, (unsigned*)(ws + WS_CTL) + CW_SK + li * 256 * 64};
                pg8::gemm_phase<pg8::EpiMoeDown, pg8::StaticOrder, true, true, true>(lds, g, S, E, tid);
                if constexpr (l == 1) {
                    const int fi = (NT * 4 - 2 * G) > 0 ? (NT * 4 - 2 * G) : 0;
                    const int nwg3 = NT * (2 * DFF / 256), fi3 = nwg3 - ((nwg3 + G - 1) / G - 1) * G;
                    if (bid >= fi) convert_moe_late(a, (bid - fi) * NWAVES + wave, (G - fi) * NWAVES, lane, fi3 < G ? MOE_LATE_SPLIT : 0, MOE_LATE_ITEMS); }
                SEAM(pb + 9); }
        }
}
__global__ void __launch_bounds__(NTHREADS, 2) mk_fwd(Args ka) {
    extern __shared__ __attribute__((aligned(16))) unsigned char lds_raw[];
    LAS unsigned char* lds = (LAS unsigned char*)lds_raw;
    __builtin_amdgcn_s_setreg(1 | (23 << 6) | (0 << 11), 1);
    const int wave_s = __builtin_amdgcn_readfirstlane((int)threadIdx.x >> 6);
    volatile LAS unsigned* MISC = (volatile LAS unsigned*)(lds + MISC_OFF);
    {
        const int t = threadIdx.x;
        if (t < 64) MISC[t] = 0u;
        if (t < N_IN + 1) { const unsigned long long* kp = (const unsigned long long*)__builtin_amdgcn_kernarg_segment_ptr(); ((LAS unsigned long long*)(lds + MISC_OFF + 256))[t] = kp[t]; }
    }
    __syncthreads();
    Ctx a0; a0.ws = ka.ws; a0.tab = (const LAS unsigned*)(lds + MISC_OFF + 256);
    unsigned* ctl = (unsigned*)(a0.ws + WS_CTL);
    const int lo = ka.ph_lo, hi = ka.ph_hi, dummy = ka.dummy;
    XcdBarrier bar; bar.bar = ctl + CW_BAR; bar.x = 0; bar.st = MISC + 8;
    if (hi - lo > 1) bar = xcd_barrier_post(ctl + CW_BAR, MISC + 8, (int)threadIdx.x);
    if (SITE(0) && IN(0)) { const int l = 0; PHASE_CTX adaln_items(a, lds, tid, lane, wave); convert_weights(a, lane, wave); SEAM(0); }

    run_layer<0>(a0, lds, wave_s, lo, hi, bar, dummy);
    run_layer<1>(a0, lds, wave_s, lo, hi, bar, dummy);
    run_layer<2>(a0, lds, wave_s, lo, hi, bar, dummy);
    run_layer<3>(a0, lds, wave_s, lo, hi, bar, dummy);
    if (SITE(14) && IN(PH_FINAL)) { const int l = 3; PHASE_CTX
        NormArgs na; na.xin = nullptr; na.X = X; na.nw = INP(I_FNW); na.sc = nullptr; na.sh = nullptr; na.g2 = MOD + (size_t)3 * 2 * 6144 + 5120; na.Y2 = Y2; na.H = nullptr; na.out = (float*)INP(N_IN); na.combine = 1; na.Y2b = nullptr;
        norm_phase<2>(a, na, lds, tid, lane, wave, nullptr, nullptr);
    }
}
#undef IN
#undef SEAM

#if MK_NAIVE_MIX
struct DbgMix { const float* gaw; const float* gab; const float* gnw; const float* convw; const float* convb; const float* dtb; const float* alog; const float* dskip; const float* snw; };
__global__ void __launch_bounds__(512) dbg_mixer(unsigned char* ws, DbgMix m) {
    __shared__ float sh_a[64], sh_q[64], sh_k[64], sh_v[128], sh_red[512], sh_o[128], sh_x[64], sh_B[64], sh_C[64], sh_s[4];
    const bf16* PROJ = (const bf16*)(ws + WS_PROJ); const float* SMALL = (const float*)(ws + WS_SMALL); bf16* MG = (bf16*)(ws + WS_MERGED); float* YT = (float*)(ws + WS_CONTRG);
    const int blk = blockIdx.x, t = threadIdx.x;
    if (blk < 8) {
        const int b = blk >> 2, h = blk & 3, v = t & 127, dg = t >> 7;
        float S[16];
        for (int i = 0; i < 16; ++i) S[i] = 0.f;
        for (int tok = 0; tok < SEQ; ++tok) {
            const size_t row = (size_t)b * SEQ + tok;
            if (t < 64) { float x = m.gab[h * 64 + t]; for (int r = 0; r < 16; ++r) x += SMALL[row * 32 + r] * m.gaw[r * 256 + h * 64 + t];
                sh_a[t] = expf(logsigmoid_f(x) * (1.0f / 16.0f)); sh_q[t] = bf2f(PROJ[row * PROJ_LD + C_Q + h * 64 + t]) * 0.125f; sh_k[t] = bf2f(PROJ[row * PROJ_LD + C_K + h * 64 + t]); }
            else if (t < 192) sh_v[t - 64] = bf2f(PROJ[row * PROJ_LD + C_V + h * 128 + t - 64]);
            __syncthreads();
            float part = 0.f;
            for (int dd = 0; dd < 16; ++dd) { const int d = dg * 16 + dd; S[dd] = sh_a[d] * S[dd] + sh_k[d] * sh_v[v]; part += sh_q[d] * S[dd]; }
            sh_red[dg * 128 + v] = part;
            __syncthreads();
            if (t < 128) sh_o[t] = (sh_red[t] + sh_red[128 + t]) + (sh_red[256 + t] + sh_red[384 + t]);
            __syncthreads();
            if (t < 128) { float ss = 0.f; for (int i = 0; i < 128; ++i) ss += sh_o[i] * sh_o[i];
                const float rstd = 1.0f / sqrtf(ss * (1.0f / 128.0f) + EPS);
                const float gt = bf2f(PROJ[row * PROJ_LD + C_G + h * 128 + t]);
                MG[row * D + h * 128 + t] = (bf16)f2bf(sh_o[t] * rstd * m.gnw[t] * silu_f(gt)); }
            __syncthreads();
        }
    } else {
        const int q = blk - 8, b = q >> 3, h = q & 7, gi = h >> 2, p = t & 63, sg = t >> 6;
        float S[8];
        for (int i = 0; i < 8; ++i) S[i] = 0.f;
        const float av = -expf(m.alog[h]);
        for (int tok = 0; tok < SEQ; ++tok) {
            const size_t row = (size_t)b * SEQ + tok;
            if (t < 192) { const int ch = t < 64 ? h * 64 + t : (t < 128 ? 512 + gi * 64 + (t - 64) : 640 + gi * 64 + (t - 128));
                float acc = m.convb[ch];
                for (int k = 0; k < 4; ++k) { const int tt = tok - 3 + k; if (tt >= 0) acc += m.convw[k * 768 + ch] * bf2f(PROJ[(row - 3 + k) * PROJ_LD + C_XS + ch]); }
                const float val = silu_f(acc);
                if (t < 64) sh_x[t] = val; else if (t < 128) sh_B[t - 64] = val; else sh_C[t - 128] = val; }
            if (t == 192) { const float dt = softplus_f(SMALL[row * 32 + 16 + h] + m.dtb[h]); sh_s[0] = dt; sh_s[1] = expf(dt * av); }
            __syncthreads();
            const float dt = sh_s[0], dec = sh_s[1];
            float part = 0.f;
            for (int ss = 0; ss < 8; ++ss) { const int s = sg * 8 + ss; S[ss] = dec * S[ss] + dt * sh_B[s] * sh_x[p]; part += sh_C[s] * S[ss]; }
            sh_red[sg * 64 + p] = part;
            __syncthreads();
            if (t < 64) { float y = 0.f; for (int i = 0; i < 8; ++i) y += sh_red[i * 64 + t];
                y += m.dskip[h] * sh_x[t]; y *= silu_f(bf2f(PROJ[row * PROJ_LD + C_Z + h * 64 + t]));
                YT[row * 512 + h * 64 + t] = y; }
            __syncthreads();
        }
    }
}
__global__ void __launch_bounds__(512) dbg_ssdnorm(unsigned char* ws, const float* snw) {
    const float* YT = (const float*)(ws + WS_CONTRG); bf16* MG = (bf16*)(ws + WS_MERGED);
    const int lane = threadIdx.x & 63, gw = blockIdx.x * 8 + (threadIdx.x >> 6);
    for (int row = gw; row < T; row += gridDim.x * 8) {
        float v[8], ss = 0.f;
        for (int i = 0; i < 8; ++i) { v[i] = YT[(size_t)row * 512 + lane + 64 * i]; ss += v[i] * v[i]; }
        for (int o = 1; o < 64; o <<= 1) ss += __shfl_xor(ss, o);
        const float rstd = 1.0f / sqrtf(ss * (1.0f / 512.0f) + EPS);
        for (int i = 0; i < 8; ++i) MG[(size_t)row * D + 512 + lane + 64 * i] = (bf16)f2bf(v[i] * rstd * snw[lane + 64 * i]);
    }
}
#endif

#if MK_MOE_CHECK
constexpr size_t WS_ERRW = WS_DECS + 65536;
DI unsigned dbg_hash(unsigned x) { x ^= x >> 16; x *= 0x7feb352du; x ^= x >> 15; x *= 0x846ca68bu; x ^= x >> 16; return x; }
DI float dbg_bfr(float f) { return bf2f(f2bf(f)); }
__global__ void __launch_bounds__(256) dbg_moe_check(unsigned char* ws, const float* router_w, const float* wg, const float* wu, const float* wd, int stage) {
    unsigned* errw = (unsigned*)(ws + WS_ERRW); const unsigned* cnt = (const unsigned*)(ws + WS_CTL) + CW_CNT;
    const bf16* HT = (const bf16*)(ws + WS_HTOK); const bf16* HS = (const bf16*)(ws + WS_H); const int* RI = (const int*)(ws + WS_ROWINFO); const bf16* HID = (const bf16*)(ws + WS_HID); const bf16* Y2 = (const bf16*)(ws + WS_Y2);
    int off[9]; { int o = 0; for (int e = 0; e < 8; ++e) { off[e] = o; o += (((int)cnt[64 * e] + 255) >> 8) << 8; } off[8] = o; }
    const int s = blockIdx.x * 256 + threadIdx.x;
    if (stage == 1) {
        const int t = dbg_hash(s * 2654435761u + 17u) % T;
        float lg[8]; for (int e = 0; e < 8; ++e) lg[e] = 0.f;
        for (int k = 0; k < D; ++k) { const float h = bf2f(HT[(size_t)t * D + k]); for (int e = 0; e < 8; ++e) lg[e] += h * router_w[k * 8 + e]; }
        int e0 = 0; for (int e = 1; e < 8; ++e) if (lg[e] > lg[e0]) e0 = e;
        int e1 = -1; for (int e = 0; e < 8; ++e) if (e != e0 && (e1 < 0 || lg[e] > lg[e1])) e1 = e;
        float third = -3e38f; for (int e = 0; e < 8; ++e) if (e != e0 && e != e1 && lg[e] > third) third = lg[e];
        const bool clear = (lg[e0] - lg[e1] > 0.05f) && (lg[e1] - third > 0.05f);
        const int* r = (const int*)(ws + WS_ROUTE + (size_t)t * 16);
        const int re0 = r[0] & 255, re1 = (r[0] >> 8) & 255; const float p0 = __builtin_bit_cast(float, r[3]);
        if (clear && (re0 != e0 || re1 != e1)) atomicOr(errw, 0u);

        const int d0 = off[re0] + r[1], d1 = off[re1] + r[2];
        const float q0 = __builtin_bit_cast(float, RI[2 * d0 + 1]), q1 = __builtin_bit_cast(float, RI[2 * d1 + 1]);
        if (fabsf(q0 - p0) > 1e-6f) atomicOr(errw, 1u);
        if (fabsf(q1 - (1.f - p0)) > 1e-6f) atomicOr(errw, 2u);
        if (fabsf(q0 - p0) > 1e-6f && q0 == 0.f) atomicOr(errw, 4u);
        if (fabsf(q1 - (1.f - p0)) > 1e-6f && q1 == 0.f) atomicOr(errw, 8u);
        if (!(p0 >= 0.5f && p0 <= 1.0f)) atomicOr(errw, 16u);
    } else {
        const int r = dbg_hash(s * 2246822519u + 5u) % off[8];
        int e = 0; for (int j = 1; j < 8; ++j) if (r >= off[j]) e = j;
        const int ti = RI[2 * r]; const float p = __builtin_bit_cast(float, RI[2 * r + 1]);
        if (ti < 0) return;
        if (stage == 2) {
            const int c = dbg_hash(s * 3266489917u + 3u) % DFF;
            float g = 0.f, u = 0.f;
            for (int k = 0; k < D; ++k) { const float h = bf2f(HS[(size_t)r * D + k]); g += h * dbg_bfr(wg[((size_t)e * D + k) * DFF + c]); u += h * dbg_bfr(wu[((size_t)e * D + k) * DFF + c]); }
            const float ref = g / (1.f + expf(-g)) * u, got = bf2f(HID[(size_t)r * DFF + c]);
            if (!(fabsf(got - ref) <= 0.03f * fabsf(ref) + 0.02f)) atomicOr(errw, 0u);
        } else {
            const int c = dbg_hash(s * 668265263u + 11u) % D;
            float y = 0.f;
            for (int k = 0; k < DFF; ++k) y += bf2f(HID[(size_t)r * DFF + k]) * dbg_bfr(wd[((size_t)e * DFF + k) * D + c]);
            const int tok = ti & 0x3fffffff, kk = ti >> 30; const float ref = y * p, got = bf2f(Y2[((size_t)kk * T + tok) * D + c]);
            if (!(fabsf(got - ref) <= 0.03f * fabsf(ref) + 0.02f)) atomicOr(errw, 0u);
        }
    }
}
__global__ void dbg_encode(unsigned char* ws, float* out) {
    const unsigned mask = *(const unsigned*)(ws + WS_ERRW);
    const size_t n = (size_t)mask * 512 * D;
    for (size_t i = (size_t)blockIdx.x * blockDim.x + threadIdx.x; i < n; i += (size_t)gridDim.x * blockDim.x) out[i] = 0.f;
}
#endif

extern "C" void kernel_launch(void* const* d_in, const int* in_sizes, int n_in, void* d_out, int out_size, void* d_ws, size_t ws_size, hipStream_t stream) {
    static int grid = 0;
    if (grid == 0) {
        if (n_in != N_IN || out_size != T * D || ws_size < WS_END) { fprintf(stderr, "kernel_launch: unexpected arguments (n_in %d, out %d, ws %zu < %zu)\n", n_in, out_size, ws_size, (size_t)WS_END); grid = -1; return; }
        int dev = 0, cus = 0, per_cu = 0;
        if (hipGetDevice(&dev) != hipSuccess || hipDeviceGetAttribute(&cus, hipDeviceAttributeMultiprocessorCount, dev) != hipSuccess) { grid = -1; return; }
        if (hipFuncSetAttribute((const void*)mk_fwd, hipFuncAttributeMaxDynamicSharedMemorySize, LDS_BYTES) != hipSuccess) { fprintf(stderr, "kernel_launch: hipFuncSetAttribute failed\n"); grid = -1; return; }
        if (hipOccupancyMaxActiveBlocksPerMultiprocessor(&per_cu, (const void*)mk_fwd, NTHREADS, LDS_BYTES) != hipSuccess || per_cu < 1) { fprintf(stderr, "kernel_launch: occupancy query says %d blocks per CU\n", per_cu); per_cu = 1; }
        (void)hipGetLastError();
        grid = cus;
    }
    if (grid < 0) return;
    (void)in_sizes;
    if (hipMemsetAsync((char*)d_ws + WS_CTL, 0, CTL_ZERO_BYTES, stream) != hipSuccess) return;
    Args a{};
    for (int i = 0; i < N_IN; ++i) a.in[i] = (const float*)d_in[i];
    a.out = (float*)d_out; a.ws = (unsigned char*)d_ws;
#if MK_PER_PHASE
    for (int ph = 0; ph < N_PHASES; ++ph) {
        if (ph >= 1 && ph < PH_FINAL) { const int l = (ph - 1) / 10, k = (ph - 1) % 10; if (k == 9 && !(l & 1)) continue; }
        a.ph_lo = ph; a.ph_hi = ph + 1;
#if defined(MK_TIME_MASK)
#ifndef MK_TIME_DUMMY
#define MK_TIME_DUMMY 1
#endif
        { const int kind = (ph == 0) ? 10 : (ph == PH_FINAL ? 11 : ((ph - 1) % 10 + (((ph - 1) / 10) & 1 && (ph - 1) % 10 >= 6 ? 6 : 0)));
          if ((MK_TIME_MASK >> kind) & 1) { a.dummy = MK_TIME_DUMMY; for (int r = 0; r < MK_TIME_REPS; ++r) hipLaunchKernelGGL(mk_fwd, dim3(grid), dim3(NTHREADS), LDS_BYTES, stream, a); a.dummy = 0; } }
#endif
#if MK_NAIVE_MIX
        if (ph >= 1 && ph < PH_FINAL) { const int l = (ph - 1) / 10, k = (ph - 1) % 10;
            if (k == 2) { DbgMix m; m.gaw = a.in[I_GAW] + (size_t)l * 16 * 256; m.gab = a.in[I_GAB] + (size_t)l * 256; m.gnw = a.in[I_GNW] + (size_t)l * 128; m.convw = a.in[I_CONVW] + (size_t)l * 4 * 768; m.convb = a.in[I_CONVB] + (size_t)l * 768;
                m.dtb = a.in[I_DTB] + (size_t)l * 8; m.alog = a.in[I_ALOG] + (size_t)l * 8; m.dskip = a.in[I_DSKIP] + (size_t)l * 8; m.snw = a.in[I_SNW] + (size_t)l * 512;
                hipLaunchKernelGGL(dbg_mixer, dim3(24), dim3(512), 0, stream, a.ws, m); continue; }
            if (k == 3) { hipLaunchKernelGGL(dbg_ssdnorm, dim3(256), dim3(512), 0, stream, a.ws, a.in[I_SNW] + (size_t)l * 512); continue; }
            if (k == 4) continue; }
#endif
        hipLaunchKernelGGL(mk_fwd, dim3(grid), dim3(NTHREADS), LDS_BYTES, stream, a);
#if MK_MOE_CHECK
        if (ph == 0) hipMemsetAsync((char*)d_ws + WS_ERRW, 0, 4, stream);
        if (ph == 11 + 7) hipLaunchKernelGGL(dbg_moe_check, dim3(8), dim3(256), 0, stream, a.ws, a.in[I_RW], a.in[I_MG], a.in[I_MU], a.in[I_MD], 1);
        if (ph == 11 + 8) hipLaunchKernelGGL(dbg_moe_check, dim3(8), dim3(256), 0, stream, a.ws, a.in[I_RW], a.in[I_MG], a.in[I_MU], a.in[I_MD], 2);
        if (ph == 11 + 9) hipLaunchKernelGGL(dbg_moe_check, dim3(8), dim3(256), 0, stream, a.ws, a.in[I_RW], a.in[I_MG], a.in[I_MU], a.in[I_MD], 3);
        if (ph == PH_FINAL) hipLaunchKernelGGL(dbg_encode, dim3(256), dim3(256), 0, stream, a.ws, a.out);
#endif
    }
#else
    a.ph_lo = 0; a.ph_hi = N_PHASES;
    hipLaunchKernelGGL(mk_fwd, dim3(grid), dim3(NTHREADS), LDS_BYTES, stream, a);
#endif
}
```
